# Optimizing an MI355X kernel written in HIP

```python
import jax, jax.numpy as jnp
from jax import lax
import numpy as np

D_MODEL = 2048
BATCH = 1
SEQ = 8192
DEPTH = 1

HEAD_DIM = 128
N_HEADS_MOBA = D_MODEL // (2 * HEAD_DIM)
N_HEADS_FOX = D_MODEL // (2 * HEAD_DIM)
MOBA_WIDTH = N_HEADS_MOBA * HEAD_DIM
FOX_WIDTH = N_HEADS_FOX * HEAD_DIM
MOBA_BLOCK = 256
MOBA_TOPK = 3
MOBA_Q_CHUNK = 64
FOX_Q_BLOCK = 128
D_FF = 4 * D_MODEL
RMS_EPS = 1e-6
IN_WIDTHS = (MOBA_WIDTH, MOBA_WIDTH, MOBA_WIDTH,
             FOX_WIDTH, FOX_WIDTH, FOX_WIDTH,
             N_HEADS_FOX,
             D_MODEL, D_MODEL)
D_IN = sum(IN_WIDTHS)

kernel_name = "moba_fox_gated_hybrid_layer"


def rms_norm(x, g):
    xf = x.astype(jnp.float32)
    y = xf * lax.rsqrt(jnp.mean(xf * xf, axis=-1, keepdims=True) + RMS_EPS)
    return (y * g.astype(jnp.float32)).astype(x.dtype)


def split_heads(t, n_heads):
    b, s, _ = t.shape
    return t.reshape(b, s, n_heads, HEAD_DIM).transpose(0, 2, 1, 3)


def merge_heads(t):
    b, h, s, d = t.shape
    return t.transpose(0, 2, 1, 3).reshape(b, s, h * d)


def to_chunks(a, c):
    a = a.reshape(a.shape[:2] + (a.shape[2] // c, c) + a.shape[3:])
    return jnp.moveaxis(a, 2, 0)


def from_chunks(a):
    a = jnp.moveaxis(a, 0, 2)
    return a.reshape(a.shape[:2] + (a.shape[2] * a.shape[3],) + a.shape[4:])


def alibi_slopes(n_heads):
    return jnp.exp2(-8.0 * jnp.arange(1, n_heads + 1, dtype=jnp.float32) / n_heads)


def moba_attention(q, k, v):
    b, h, s, d = q.shape
    s_pad = -(-s // MOBA_BLOCK) * MOBA_BLOCK
    pad = ((0, 0), (0, 0), (0, s_pad - s), (0, 0))
    q, k, v = jnp.pad(q, pad), jnp.pad(k, pad), jnp.pad(v, pad)
    nb = s_pad // MOBA_BLOCK
    n_sel = min(MOBA_TOPK, nb)
    scale = HEAD_DIM ** -0.5
    slopes = alibi_slopes(h)[None, :, None]
    kb = k.reshape(b, h, nb, MOBA_BLOCK, d)
    vb = v.reshape(b, h, nb, MOBA_BLOCK, d)
    kmean = jnp.mean(kb.astype(jnp.float32), axis=3)
    gate = jnp.einsum('bhtd,bhnd->bhtn', q.astype(jnp.float32), kmean)
    q_blk = jnp.arange(s_pad) // MOBA_BLOCK
    past = jnp.arange(nb)[None, :] < q_blk[:, None]
    gate = jnp.where(past, gate, -jnp.inf)
    top_vals, sel = lax.top_k(gate, n_sel)
    valid = jnp.isfinite(top_vals)
    bi = jnp.arange(b)[:, None, None, None]
    hi = jnp.arange(h)[None, :, None, None]
    blk_off = jnp.arange(MOBA_BLOCK)

    def chunk(args):
        ci, qc, selc, validc = args
        q_pos = ci * MOBA_Q_CHUNK + jnp.arange(MOBA_Q_CHUNK)
        own = (ci * MOBA_Q_CHUNK) // MOBA_BLOCK
        k_own = lax.dynamic_index_in_dim(kb, own, axis=2, keepdims=False)
        v_own = lax.dynamic_index_in_dim(vb, own, axis=2, keepdims=False)
        dist_own = (q_pos[:, None] - (own * MOBA_BLOCK + blk_off)[None, :])
        s_own = jnp.einsum('bhcd,bhsd->bhcs', qc, k_own).astype(jnp.float32) * scale
        s_own = s_own - slopes[..., None] * jnp.abs(dist_own).astype(jnp.float32)
        s_own = jnp.where(dist_own >= 0, s_own, -jnp.inf)
        k_sel = kb[bi, hi, selc]
        v_sel = vb[bi, hi, selc]
        s_sel = jnp.einsum('bhcd,bhcjsd->bhcjs', qc, k_sel).astype(jnp.float32) * scale
        sel_pos = selc[..., None] * MOBA_BLOCK + blk_off
        dist_sel = jnp.abs(q_pos[None, None, :, None, None] - sel_pos).astype(jnp.float32)
        s_sel = s_sel - slopes[..., None, None] * dist_sel
        s_sel = jnp.where(validc[..., None], s_sel, -jnp.inf)
        c, j = selc.shape[2], selc.shape[3]
        scores = jnp.concatenate([s_sel.reshape(b, h, c, j * MOBA_BLOCK), s_own], axis=-1)
        p = jax.nn.softmax(scores, axis=-1).astype(v.dtype)
        p_sel = p[..., :j * MOBA_BLOCK].reshape(b, h, c, j, MOBA_BLOCK)
        p_own = p[..., j * MOBA_BLOCK:]
        return (jnp.einsum('bhcjs,bhcjsd->bhcd', p_sel, v_sel)
                + jnp.einsum('bhcs,bhsd->bhcd', p_own, v_own))

    nc = s_pad // MOBA_Q_CHUNK
    out = lax.map(chunk, (jnp.arange(nc), to_chunks(q, MOBA_Q_CHUNK),
                          to_chunks(sel, MOBA_Q_CHUNK), to_chunks(valid, MOBA_Q_CHUNK)))
    return from_chunks(out)[:, :, :s]


def forgetting_attention(q, k, v, f_logit, b_forget):
    b, h, s, d = q.shape
    scale = HEAD_DIM ** -0.5
    log_f = jax.nn.log_sigmoid(f_logit.astype(jnp.float32) + b_forget.astype(jnp.float32))
    c = jnp.cumsum(log_f, axis=1).transpose(0, 2, 1)
    key_pos = jnp.arange(s)

    def chunk(args):
        ci, qc, cq = args
        sc = jnp.einsum('bhcd,bhsd->bhcs', qc, k).astype(jnp.float32) * scale
        sc = sc + cq[..., None] - c[:, :, None, :]
        q_pos = ci * FOX_Q_BLOCK + jnp.arange(FOX_Q_BLOCK)
        sc = jnp.where(q_pos[:, None] >= key_pos[None, :], sc, -jnp.inf)
        p = jax.nn.softmax(sc, axis=-1).astype(v.dtype)
        return jnp.einsum('bhcs,bhsd->bhcd', p, v)

    nc = s // FOX_Q_BLOCK
    cq = c.reshape(b, h, nc, FOX_Q_BLOCK).transpose(2, 0, 1, 3)
    out = lax.map(chunk, (jnp.arange(nc), to_chunks(q, FOX_Q_BLOCK), cq))
    return from_chunks(out)


def setup_inputs(seed: int = 0) -> dict:
    key = jax.random.key(seed)
    ks = jax.random.split(key, 11)
    f32 = jnp.float32
    def normal(k, shape, scale):
        return jax.random.normal(k, shape, f32) * scale
    return {
        "x": normal(ks[0], (BATCH, SEQ, D_MODEL), 1.0),
        "norm_mix_g": 1.0 + normal(ks[1], (D_MODEL,), 0.02),
        "w_in": normal(ks[2], (D_MODEL, D_IN), D_MODEL ** -0.5),
        "b_forget": 2.0 + normal(ks[3], (N_HEADS_FOX,), 0.5),
        "w_proj_a": normal(ks[4], (MOBA_WIDTH, D_MODEL), MOBA_WIDTH ** -0.5),
        "w_proj_b": normal(ks[5], (FOX_WIDTH, D_MODEL), FOX_WIDTH ** -0.5),
        "w_out": normal(ks[6], (D_MODEL, D_MODEL), D_MODEL ** -0.5),
        "norm_mlp_g": 1.0 + normal(ks[7], (D_MODEL,), 0.02),
        "w_up": normal(ks[8], (D_MODEL, D_FF), D_MODEL ** -0.5),
        "w_down": normal(ks[9], (D_FF, D_MODEL), D_FF ** -0.5),
        "norm_final_g": 1.0 + normal(ks[10], (D_MODEL,), 0.02),
    }


def reference(x, norm_mix_g, w_in, b_forget, w_proj_a, w_proj_b, w_out,
              norm_mlp_g, w_up, w_down, norm_final_g):
    split_idx = list(np.cumsum(IN_WIDTHS)[:-1])
    for _ in range(DEPTH):
        hn = rms_norm(x, norm_mix_g)
        z = hn @ w_in
        q_a, k_a, v_a, q_b, k_b, v_b, f_logit, g_a, g_b = jnp.split(z, split_idx, axis=-1)
        a = moba_attention(split_heads(q_a, N_HEADS_MOBA), split_heads(k_a, N_HEADS_MOBA),
                           split_heads(v_a, N_HEADS_MOBA))
        bfx = forgetting_attention(split_heads(q_b, N_HEADS_FOX), split_heads(k_b, N_HEADS_FOX),
                                   split_heads(v_b, N_HEADS_FOX), f_logit, b_forget)
        a = merge_heads(a) @ w_proj_a
        bfx = merge_heads(bfx) @ w_proj_b
        merged = jax.nn.sigmoid(g_a) * a + jax.nn.sigmoid(g_b) * bfx
        x = x + merged @ w_out
        hm = rms_norm(x, norm_mlp_g)
        x = x + jnp.square(jax.nn.relu(hm @ w_up)) @ w_down
    return rms_norm(x, norm_final_g)
```

```cpp
#include <hip/hip_runtime.h>
#include <cstdio>
#include <cstdint>

typedef unsigned short bf16;
constexpr int S = 8192, D = 2048, NH = 8, HD = 128, MW = 1024, FF = 8192, DIN = 10248, NZ = 10240;
constexpr float EPS = 1e-6f;
constexpr float LOG2E = 1.4426950408889634f;
constexpr float C2 = 0.08838834764831845f * 1.4426950408889634f;
constexpr double FIX = 4294967296.0;

constexpr size_t MiB = 1u << 20;
constexpr size_t WS_CTL = 0, CTL_ZERO_BYTES = 1 * MiB;
constexpr size_t CT_SSQ1 = 64 * 1024, CT_SSQ2 = 128 * 1024, CT_KMEAN = 256 * 1024;
constexpr size_t WS_FLOG = 1 * MiB, WS_CBN = WS_FLOG + 256 * 1024, WS_SEL = WS_CBN + 256 * 1024;
constexpr size_t WS_WIN = 2 * MiB, WS_WA = 42 * MiB, WS_WB = 46 * MiB, WS_WOUT = 50 * MiB, WS_WUP = 58 * MiB, WS_WDN = 90 * MiB;
constexpr size_t WS_XN = 122 * MiB, WS_MERGED = WS_XN;
constexpr size_t WS_QKV = 154 * MiB, WS_SIG = 250 * MiB, WS_END = 314 * MiB;
constexpr size_t WS_AM = 2 * MiB, WS_AF = 18 * MiB, WS_X1G = 2 * MiB, WS_H = 154 * MiB;
constexpr size_t QKV_T = (size_t)NH * S * HD;

__device__ __forceinline__ float bf2f(bf16 v) { return __uint_as_float((unsigned)v << 16); }
__device__ __forceinline__ bf16 f2bf(float f) { unsigned u = __float_as_uint(f); return (bf16)((u + 0x7fffu + ((u >> 16) & 1u)) >> 16); }
__device__ __forceinline__ float wave_sum(float v) {
#pragma unroll
    for (int o = 1; o < 64; o <<= 1) v += __shfl_xor(v, o);
    return v;
}
__device__ __forceinline__ float wave_max(float v) {
#pragma unroll
    for (int o = 1; o < 64; o <<= 1) v = fmaxf(v, __shfl_xor(v, o));
    return v;
}

__global__ void __launch_bounds__(256) k_transpose(const float* __restrict__ W, int K, int Nsrc, int split, int skip, bf16* __restrict__ WT) {
    __shared__ float tile[32][33];
    const int tx = threadIdx.x & 31, ty = threadIdx.x >> 5, n0 = blockIdx.x * 32, k0 = blockIdx.y * 32;
    const int sc = n0 + tx < split ? n0 + tx : n0 + tx + skip;
#pragma unroll
    for (int j = 0; j < 4; ++j) { const int kk = ty + 8 * j; tile[kk][tx] = W[(size_t)(k0 + kk) * Nsrc + sc]; }
    __syncthreads();
#pragma unroll
    for (int j = 0; j < 4; ++j) { const int n = ty + 8 * j; WT[(size_t)(n0 + n) * K + k0 + tx] = f2bf(tile[tx][n]); }
}
__global__ void __launch_bounds__(256) k_norm_x(const float* __restrict__ x, const float* __restrict__ g, const float* __restrict__ w_in, bf16* __restrict__ XN, float* __restrict__ flog) {
    __shared__ float red[4][9];
    const int t = blockIdx.x, tid = threadIdx.x, lane = tid & 63, wid = tid >> 6;
    float v[8]; float ss = 0.f;
#pragma unroll
    for (int j = 0; j < 8; ++j) { v[j] = x[(size_t)t * D + tid + 256 * j]; ss += v[j] * v[j]; }
    ss = wave_sum(ss); if (lane == 0) red[wid][8] = ss; __syncthreads();
    const float rstd = 1.0f / sqrtf((red[0][8] + red[1][8] + red[2][8] + red[3][8]) * (1.0f / D) + EPS);
    float f[8];
#pragma unroll
    for (int h = 0; h < 8; ++h) f[h] = 0.f;
#pragma unroll
    for (int j = 0; j < 8; ++j) { const int k = tid + 256 * j; const float hn = v[j] * rstd * g[k]; XN[(size_t)t * D + k] = f2bf(hn);
#pragma unroll
        for (int h = 0; h < 8; ++h) f[h] += hn * w_in[(size_t)k * DIN + 6144 + h]; }
#pragma unroll
    for (int h = 0; h < 8; ++h) { f[h] = wave_sum(f[h]); if (lane == 0) red[wid][h] = f[h]; }
    __syncthreads();
    if (tid < 8) flog[t * 8 + tid] = red[0][tid] + red[1][tid] + red[2][tid] + red[3][tid];
}
template <class Epi>
__global__ void __launch_bounds__(256) k_gemm(const bf16* __restrict__ A, int lda, const bf16* __restrict__ Bt, int ldb, int K, Epi e) {
    __shared__ float As[16][65], Bs[16][65];
    const int tid = threadIdx.x, tx = tid & 15, ty = tid >> 4, row0 = blockIdx.y * 64, col0 = blockIdx.x * 64;
    float acc[4][4];
#pragma unroll
    for (int i = 0; i < 4; ++i)
#pragma unroll
        for (int j = 0; j < 4; ++j) acc[i][j] = 0.f;
    for (int k0 = 0; k0 < K; k0 += 16) {
#pragma unroll
        for (int i = 0; i < 4; ++i) { const int idx = tid + 256 * i, r = idx >> 4, kk = idx & 15;
            As[kk][r] = bf2f(A[(size_t)(row0 + r) * lda + k0 + kk]); Bs[kk][r] = bf2f(Bt[(size_t)(col0 + r) * ldb + k0 + kk]); }
        __syncthreads();
#pragma unroll
        for (int kk = 0; kk < 16; ++kk) { float a[4], b[4];
#pragma unroll
            for (int i = 0; i < 4; ++i) { a[i] = As[kk][ty * 4 + i]; b[i] = Bs[kk][tx * 4 + i]; }
#pragma unroll
            for (int i = 0; i < 4; ++i)
#pragma unroll
                for (int j = 0; j < 4; ++j) acc[i][j] += a[i] * b[j]; }
        __syncthreads();
    }
#pragma unroll
    for (int i = 0; i < 4; ++i)
#pragma unroll
        for (int j = 0; j < 4; ++j) e(row0 + ty * 4 + i, col0 + tx * 4 + j, acc[i][j]);
}
struct EpiZ { bf16* qkv; bf16* sig;
    __device__ void operator()(int r, int c, float v) const {
        if (c < 6144) { const int ti = c >> 10, hh = (c & 1023) >> 7, d = c & 127; if (ti == 0 || ti == 3) v *= C2; qkv[((size_t)(ti * 8 + hh) * S + r) * HD + d] = f2bf(v); }
        else { const int gi = (c - 6144) >> 11, cc = (c - 6144) & 2047; sig[((size_t)gi * S + r) * D + cc] = f2bf(1.0f / (1.0f + __builtin_amdgcn_exp2f(-v * LOG2E))); }
    } };
struct EpiPa { const bf16* sig; bf16* merged;
    __device__ void operator()(int r, int c, float v) const { merged[(size_t)r * D + c] = f2bf(bf2f(sig[(size_t)r * D + c]) * v); } };
struct EpiPb { const bf16* sig; bf16* merged;
    __device__ void operator()(int r, int c, float v) const { const size_t i = (size_t)r * D + c; merged[i] = f2bf(bf2f(merged[i]) + bf2f(sig[(size_t)S * D + i]) * v); } };
struct EpiOut { const float* x; const float* g; float* x1; bf16* x1g; unsigned long long* ssq;
    __device__ void operator()(int r, int c, float v) const { const size_t i = (size_t)r * D + c; const float y = x[i] + v; x1[i] = y; x1g[i] = f2bf(y * g[c]);
        atomicAdd(ssq + r, (unsigned long long)((double)(y * y) * FIX)); } };
struct EpiUp { const unsigned long long* ssq; bf16* h;
    __device__ void operator()(int r, int c, float v) const { const float r2 = 1.0f / ((float)((double)ssq[r] * (1.0 / FIX)) * (1.0f / D) + EPS); const float u = fmaxf(v, 0.f); h[(size_t)r * FF + c] = f2bf(u * u * r2); } };
struct EpiDn { float* x2; unsigned long long* ssq;
    __device__ void operator()(int r, int c, float v) const { const size_t i = (size_t)r * D + c; const float y = x2[i] + v; x2[i] = y; atomicAdd(ssq + r, (unsigned long long)((double)(y * y) * FIX)); } };

__global__ void __launch_bounds__(128) k_kmean(const bf16* __restrict__ ka, float* __restrict__ km) {
    const int hn = blockIdx.x, h = hn >> 5, n = hn & 31, d = threadIdx.x; float s = 0.f;
    for (int i = 0; i < 256; ++i) s += bf2f(ka[((size_t)h * S + n * 256 + i) * HD + d]);
    km[(size_t)hn * HD + d] = s;
}
struct Top3 { float v0, v1, v2; int i0, i1, i2; };
__device__ __forceinline__ void top3_insert(Top3& T, float v, int n) {
    const bool b0 = v > T.v0 || (v == T.v0 && n < T.i0), b1 = v > T.v1 || (v == T.v1 && n < T.i1), b2 = v > T.v2 || (v == T.v2 && n < T.i2);
    if (b0) { T.v2 = T.v1; T.i2 = T.i1; T.v1 = T.v0; T.i1 = T.i0; T.v0 = v; T.i0 = n; }
    else if (b1) { T.v2 = T.v1; T.i2 = T.i1; T.v1 = v; T.i1 = n; }
    else if (b2) { T.v2 = v; T.i2 = n; }
}
__device__ __forceinline__ void route_item(int h, int b, const bf16* __restrict__ qa, const float* __restrict__ km, unsigned* __restrict__ selmask, float* lds  ) {
    const int tid = threadIdx.x;
    float* kml = lds; float* xv = lds + 4096; int* xi = (int*)(lds + 4096 + 768);
    for (int i = tid; i < 4096; i += 512) kml[i] = km[(size_t)h * 4096 + i];
    __syncthreads();
    const int q = tid & 255, par = tid >> 8, t = b * 256 + q;
    float g[16];
#pragma unroll
    for (int i = 0; i < 16; ++i) g[i] = 0.f;
    const bf16* qrow = qa + ((size_t)h * S + t) * HD;
    for (int d0 = 0; d0 < 128; d0 += 8) {
        const uint4 raw = *(const uint4*)(qrow + d0);
        float qv[8]; qv[0] = __uint_as_float(raw.x << 16); qv[1] = __uint_as_float(raw.x & 0xffff0000u); qv[2] = __uint_as_float(raw.y << 16); qv[3] = __uint_as_float(raw.y & 0xffff0000u);
        qv[4] = __uint_as_float(raw.z << 16); qv[5] = __uint_as_float(raw.z & 0xffff0000u); qv[6] = __uint_as_float(raw.w << 16); qv[7] = __uint_as_float(raw.w & 0xffff0000u);
#pragma unroll
        for (int i = 0; i < 16; ++i) { const float* kr = kml + (2 * i + par) * 128 + d0;
#pragma unroll
            for (int e = 0; e < 8; ++e) g[i] += qv[e] * kr[e]; }
    }
    Top3 T; T.v0 = T.v1 = T.v2 = -INFINITY; T.i0 = T.i1 = T.i2 = 1 << 20;
#pragma unroll
    for (int i = 0; i < 16; ++i) { const int n = 2 * i + par; if (n < b) top3_insert(T, g[i], n); }
    if (par == 1) { xv[q] = T.v0; xv[256 + q] = T.v1; xv[512 + q] = T.v2; xi[q] = T.i0; xi[256 + q] = T.i1; xi[512 + q] = T.i2; }
    __syncthreads();
    if (par == 0) {
        top3_insert(T, xv[q], xi[q]); top3_insert(T, xv[256 + q], xi[256 + q]); top3_insert(T, xv[512 + q], xi[512 + q]);
        unsigned m = 1u << b;
        if (T.v0 > -INFINITY) m |= 1u << T.i0; if (T.v1 > -INFINITY) m |= 1u << T.i1; if (T.v2 > -INFINITY) m |= 1u << T.i2;
        selmask[(size_t)h * S + t] = m;
    }
    __syncthreads();
}
__global__ void __launch_bounds__(512) k_route(const bf16* __restrict__ qa, const float* __restrict__ km, unsigned* __restrict__ selmask) {
    __shared__ float lds[4096 + 6 * 256];
    route_item(blockIdx.x >> 5, blockIdx.x & 31, qa, km, selmask, lds);
}
__device__ __forceinline__ void scan_head(int h, const float* __restrict__ flog, const float* __restrict__ bfg, float* __restrict__ cbn, double* lds  ) {
    const int tid = threadIdx.x; const float bh = bfg[h];
    float lf[16]; double s = 0.0;
#pragma unroll
    for (int i = 0; i < 16; ++i) { const float z = flog[(size_t)(tid * 16 + i) * 8 + h] + bh; lf[i] = fminf(z, 0.f) - log1pf(expf(-fabsf(z))); s += (double)lf[i]; }
    lds[tid] = s; __syncthreads();
    for (int o = 1; o < 512; o <<= 1) { double v = tid >= o ? lds[tid - o] : 0.0; __syncthreads(); lds[tid] += v; __syncthreads(); }
    double run = tid ? lds[tid - 1] : 0.0;
#pragma unroll
    for (int i = 0; i < 16; ++i) { run += (double)lf[i]; cbn[(size_t)h * S + tid * 16 + i] = (float)(-run * 1.4426950408889634); }
    __syncthreads();
}
__global__ void __launch_bounds__(512) k_scan(const float* __restrict__ flog, const float* __restrict__ bfg, float* __restrict__ cbn) {
    __shared__ double lds[512];
    scan_head(blockIdx.x, flog, bfg, cbn, lds);
}
__global__ void __launch_bounds__(256) k_attn_naive(const bf16* __restrict__ Q, const bf16* __restrict__ K, const bf16* __restrict__ V, const float* __restrict__ cbn,
                                                    const unsigned* __restrict__ selmask, bf16* __restrict__ A, int mode) {
    __shared__ float qs[4][128]; __shared__ float ps[4][64];
    const int tid = threadIdx.x, lane = tid & 63, wid = tid >> 6, qi = blockIdx.x * 4 + wid, h = qi / S, t = qi % S;
    const bf16* qrow = Q + ((size_t)h * S + t) * HD; qs[wid][lane] = bf2f(qrow[lane]); qs[wid][lane + 64] = bf2f(qrow[lane + 64]);
    __syncthreads();
    const float slope2 = exp2f(-(float)(h + 1)) * LOG2E; const unsigned sm = mode ? selmask[(size_t)h * S + t] : 0xffffffffu;
    const float cbt = mode ? 0.f : cbn[(size_t)h * S + t];
    float m = -1e30f, l = 0.f, o0 = 0.f, o1 = 0.f;
    for (int kb = 0; kb <= t; kb += 64) {
        if (mode && !((sm >> (kb >> 8)) & 1u)) continue;
        const int key = kb + lane; const bool valid = key <= t; float s = -INFINITY;
        if (valid) { const bf16* kr = K + ((size_t)h * S + key) * HD; float a = 0.f;
            for (int d = 0; d < 128; d += 8) { const uint4 raw = *(const uint4*)(kr + d); const float* qq = &qs[wid][d];
                a += qq[0] * __uint_as_float(raw.x << 16) + qq[1] * __uint_as_float(raw.x & 0xffff0000u) + qq[2] * __uint_as_float(raw.y << 16) + qq[3] * __uint_as_float(raw.y & 0xffff0000u)
                   + qq[4] * __uint_as_float(raw.z << 16) + qq[5] * __uint_as_float(raw.z & 0xffff0000u) + qq[6] * __uint_as_float(raw.w << 16) + qq[7] * __uint_as_float(raw.w & 0xffff0000u); }
            s = mode ? a - slope2 * (float)(t - key) : a + cbn[(size_t)h * S + key] - cbt; }
        const float cm = wave_max(s), mn = fmaxf(m, cm), alpha = __builtin_amdgcn_exp2f(m - mn), p = valid ? __builtin_amdgcn_exp2f(s - mn) : 0.f;
        l = l * alpha + wave_sum(p); o0 *= alpha; o1 *= alpha; m = mn;
        ps[wid][lane] = p; asm volatile("s_waitcnt lgkmcnt(0)" ::: "memory"); __builtin_amdgcn_wave_barrier();
        const bf16* vb = V + ((size_t)h * S + kb) * HD;
        const int nk = (t - kb + 1) < 64 ? (t - kb + 1) : 64;
        for (int j = 0; j < nk; ++j) { const float pj = ps[wid][j]; o0 += pj * bf2f(vb[(size_t)j * HD + lane]); o1 += pj * bf2f(vb[(size_t)j * HD + lane + 64]); }
        asm volatile("s_waitcnt lgkmcnt(0)" ::: "memory"); __builtin_amdgcn_wave_barrier();
    }
    const float il = 1.0f / l;
    A[(size_t)t * MW + h * HD + lane] = f2bf(o0 * il); A[(size_t)t * MW + h * HD + lane + 64] = f2bf(o1 * il);
}
__global__ void __launch_bounds__(256) k_final(float* __restrict__ out, const unsigned long long* __restrict__ ssq, const float* __restrict__ g) {
    const int t = blockIdx.x; const float rstd = 1.0f / sqrtf((float)((double)ssq[t] * (1.0 / FIX)) * (1.0f / D) + EPS);
    for (int c = threadIdx.x; c < D; c += 256) out[(size_t)t * D + c] = out[(size_t)t * D + c] * rstd * g[c];
}

extern "C" void kernel_launch(void* const* d_in, const int* in_sizes, int n_in, void* d_out, int out_size, void* d_ws, size_t ws_size, hipStream_t stream) {
    if (n_in != 11 || in_sizes[0] != S * D || out_size != S * D || ws_size < WS_END) { fprintf(stderr, "kernel_launch: unexpected shapes / workspace (n_in %d, ws %zu)\n", n_in, ws_size); return; }
    const float* x = (const float*)d_in[0]; const float* g_mix = (const float*)d_in[1]; const float* w_in = (const float*)d_in[2]; const float* b_forget = (const float*)d_in[3];
    const float* w_pa = (const float*)d_in[4]; const float* w_pb = (const float*)d_in[5]; const float* w_out = (const float*)d_in[6]; const float* g_mlp = (const float*)d_in[7];
    const float* w_up = (const float*)d_in[8]; const float* w_dn = (const float*)d_in[9]; const float* g_fin = (const float*)d_in[10];
    unsigned char* ws = (unsigned char*)d_ws; float* out = (float*)d_out;
    bf16* WIN = (bf16*)(ws + WS_WIN); bf16* WA = (bf16*)(ws + WS_WA); bf16* WB = (bf16*)(ws + WS_WB); bf16* WOUT = (bf16*)(ws + WS_WOUT); bf16* WUP = (bf16*)(ws + WS_WUP); bf16* WDN = (bf16*)(ws + WS_WDN);
    bf16* XN = (bf16*)(ws + WS_XN); bf16* MERGED = (bf16*)(ws + WS_MERGED); bf16* QKV = (bf16*)(ws + WS_QKV); bf16* SIG = (bf16*)(ws + WS_SIG);
    bf16* AM = (bf16*)(ws + WS_AM); bf16* AF = (bf16*)(ws + WS_AF); bf16* X1G = (bf16*)(ws + WS_X1G); bf16* HB = (bf16*)(ws + WS_H);
    float* FLOG = (float*)(ws + WS_FLOG); float* CBN = (float*)(ws + WS_CBN); unsigned* SEL = (unsigned*)(ws + WS_SEL);
    unsigned long long* SSQ1 = (unsigned long long*)(ws + CT_SSQ1); unsigned long long* SSQ2 = (unsigned long long*)(ws + CT_SSQ2); float* KM = (float*)(ws + CT_KMEAN);
    (void)hipMemsetAsync(ws + WS_CTL, 0, CTL_ZERO_BYTES, stream);
    k_transpose<<<dim3(NZ / 32, D / 32), 256, 0, stream>>>(w_in, D, DIN, 6144, 8, WIN);
    k_transpose<<<dim3(D / 32, MW / 32), 256, 0, stream>>>(w_pa, MW, D, 1 << 30, 0, WA);
    k_transpose<<<dim3(D / 32, MW / 32), 256, 0, stream>>>(w_pb, MW, D, 1 << 30, 0, WB);
    k_transpose<<<dim3(D / 32, D / 32), 256, 0, stream>>>(w_out, D, D, 1 << 30, 0, WOUT);
    k_transpose<<<dim3(FF / 32, D / 32), 256, 0, stream>>>(w_up, D, FF, 1 << 30, 0, WUP);
    k_transpose<<<dim3(D / 32, FF / 32), 256, 0, stream>>>(w_dn, FF, D, 1 << 30, 0, WDN);
    k_norm_x<<<S, 256, 0, stream>>>(x, g_mix, w_in, XN, FLOG);
    k_gemm<EpiZ><<<dim3(NZ / 64, S / 64), 256, 0, stream>>>(XN, D, WIN, D, D, EpiZ{QKV, SIG});
    k_kmean<<<256, 128, 0, stream>>>(QKV + 1 * QKV_T, KM);
    k_route<<<256, 512, 0, stream>>>(QKV, KM, SEL);
    k_scan<<<8, 512, 0, stream>>>(FLOG, b_forget, CBN);
    k_attn_naive<<<NH * S / 4, 256, 0, stream>>>(QKV + 0 * QKV_T, QKV + 1 * QKV_T, QKV + 2 * QKV_T, CBN, SEL, AM, 1);
    k_attn_naive<<<NH * S / 4, 256, 0, stream>>>(QKV + 3 * QKV_T, QKV + 4 * QKV_T, QKV + 5 * QKV_T, CBN, SEL, AF, 0);
    k_gemm<EpiPa><<<dim3(D / 64, S / 64), 256, 0, stream>>>(AM, MW, WA, MW, MW, EpiPa{SIG, MERGED});
    k_gemm<EpiPb><<<dim3(D / 64, S / 64), 256, 0, stream>>>(AF, MW, WB, MW, MW, EpiPb{SIG, MERGED});
    k_gemm<EpiOut><<<dim3(D / 64, S / 64), 256, 0, stream>>>(MERGED, D, WOUT, D, D, EpiOut{x, g_mlp, out, X1G, SSQ1});
    k_gemm<EpiUp><<<dim3(FF / 64, S / 64), 256, 0, stream>>>(X1G, D, WUP, D, D, EpiUp{SSQ1, HB});
    k_gemm<EpiDn><<<dim3(D / 64, S / 64), 256, 0, stream>>>(HB, FF, WDN, FF, FF, EpiDn{out, SSQ2});
    k_final<<<S, 256, 0, stream>>>(out, SSQ2, g_fin);
}
```

```cpp
#include <hip/hip_runtime.h>
#include <cstdio>
#include <cstdint>

typedef unsigned short bf16;
constexpr int S = 8192, D = 2048, NH = 8, HD = 128, MW = 1024, FF = 8192, DIN = 10248, NZ = 10240;
constexpr float EPS = 1e-6f;
constexpr float LOG2E = 1.4426950408889634f;
constexpr float C2 = 0.08838834764831845f * 1.4426950408889634f;
constexpr double FIX = 4294967296.0;

constexpr size_t MiB = 1u << 20;
constexpr size_t WS_CTL = 0, CTL_ZERO_BYTES = 1 * MiB;
constexpr size_t CT_SSQ1 = 64 * 1024, CT_SSQ2 = 128 * 1024, CT_KMEAN = 256 * 1024;
constexpr int CW_BAR = 4096;
constexpr size_t WS_FLOG = 1 * MiB, WS_CBN = WS_FLOG + 256 * 1024, WS_SEL = WS_CBN + 256 * 1024;
constexpr size_t WS_WIN = 2 * MiB, WS_WA = 42 * MiB, WS_WB = 46 * MiB, WS_WOUT = 50 * MiB, WS_WUP = 58 * MiB, WS_WDN = 90 * MiB;
constexpr size_t WS_XN = 122 * MiB, WS_MERGED = WS_XN;
constexpr size_t WS_QKV = 154 * MiB, WS_SIG = 250 * MiB, WS_END = 314 * MiB;
constexpr size_t WS_AM = 2 * MiB, WS_AF = 18 * MiB, WS_X1G = 2 * MiB, WS_H = 154 * MiB;
constexpr size_t QKV_T = (size_t)NH * S * HD;

__device__ __forceinline__ float bf2f(bf16 v) { return __uint_as_float((unsigned)v << 16); }
__device__ __forceinline__ float wave_sum(float v) {
#pragma unroll
    for (int o = 1; o < 64; o <<= 1) v += __shfl_xor(v, o);
    return v;
}
__device__ __forceinline__ float wave_max(float v) {
#pragma unroll
    for (int o = 1; o < 64; o <<= 1) v = fmaxf(v, __shfl_xor(v, o));
    return v;
}
namespace pg8 {
#define PG8_LAS __attribute__((address_space(3)))
typedef unsigned short bf16_t;
typedef short bf16x8 __attribute__((ext_vector_type(8)));
typedef float f32x4 __attribute__((ext_vector_type(4)));
typedef unsigned u32x4 __attribute__((ext_vector_type(4)));
constexpr int BM = 256, BK = 64, HALF = 128, HTB = HALF * BK * 2  , STAGE_BYTES = 8 * HTB, NXCD = 8, WGM = 8;

__host__ __device__ __forceinline__ int lds_byte(int r, int c) { const int st = (r >> 4) * 2 + (c >> 5), rr = r & 15, cc = c & 31, ob = rr * 64 + cc * 2; return st * 1024 + (ob ^ (((ob >> 9) & 1) << 5)); }
__host__ __device__ __forceinline__ void stage_rc(int b, int& R, int& C) { const int st = b / 1024, sb = b % 1024, swz = sb ^ (((sb >> 9) & 1) << 5); R = (st >> 1) * 16 + swz / 64; C = (st & 1) * 32 + (swz % 64) / 2; }
__host__ __device__ __forceinline__ int perm32(int rho) { const int n = rho >> 4, i = rho & 15; return 8 * (i >> 2) + 4 * n + (i & 3); }

struct Unit { int pm, pn, seg; };
struct Gemm { const bf16_t* A0; const bf16_t* A1; const bf16_t* B0; const bf16_t* B1; int K; };

struct StaticOrder {
    int nM, nN, nwg, G, c;
    __host__ __device__ void init(int M, int N, int G_, int c_) { nM = M / BM; nN = N / BM; nwg = nM * nN; G = G_; c = c_; }
    __host__ __device__ bool next(int i, Unit& u) const {
        const long L = (long)i * G + c; if (L >= nwg) return false;
        int wgid = (int)L; { const int q = nwg / NXCD, r = nwg % NXCD, xcd = wgid % NXCD, off = wgid / NXCD; wgid = (xcd < r ? xcd * (q + 1) : r * (q + 1) + (xcd - r) * q) + off; }
        const int nig = WGM * nN, gid = wgid / nig, fm = gid * WGM, gsz = (nM - fm) < WGM ? (nM - fm) : WGM;
        u.pm = fm + ((wgid % nig) % gsz); u.pn = (wgid % nig) / gsz; u.seg = 0; return true;
    }
    __device__ __forceinline__ void a_ready(const Unit&) const {}
    __device__ __forceinline__ void done(const Unit&) const {}
};

typedef float f32x2_t __attribute__((ext_vector_type(2))); typedef __bf16 bf16x2_t __attribute__((ext_vector_type(2)));
__device__ __forceinline__ unsigned cvt_pk_bf16(float lo, float hi) { f32x2_t v = {lo, hi}; bf16x2_t b = __builtin_convertvector(v, bf16x2_t); return __builtin_bit_cast(unsigned, b); }
typedef unsigned u32x2 __attribute__((ext_vector_type(2)));
__device__ __forceinline__ float sigmoidf_fast(float v) { return __builtin_amdgcn_rcpf(1.0f + __builtin_amdgcn_exp2f(-v * LOG2E)); }
__device__ __forceinline__ void unpack8(const u32x4 w, float (&f)[8]) {
    f[0] = __uint_as_float(w.x << 16); f[1] = __uint_as_float(w.x & 0xffff0000u); f[2] = __uint_as_float(w.y << 16); f[3] = __uint_as_float(w.y & 0xffff0000u);
    f[4] = __uint_as_float(w.z << 16); f[5] = __uint_as_float(w.z & 0xffff0000u); f[6] = __uint_as_float(w.w << 16); f[7] = __uint_as_float(w.w & 0xffff0000u);
}
struct EpiIn {
    static constexpr bool PERM = true, AFTER_DRAIN = false, TWO_SEG = false;
    bf16_t* qkv; bf16_t* sig; float* km;
    __device__ __forceinline__ void operator()(const f32x4 (&acc)[2][2][4][2], const Unit& u, int wr, int wc, int fr, int fq) const {
        const int row0 = u.pm * BM + wr * 64 + fr;
        if (u.pn < 24) {
            const int ti = u.pn >> 2; const float sc = (ti == 0 || ti == 3) ? C2 : 1.0f;
#pragma unroll
            for (int bj = 0; bj < 2; ++bj) { const int head = 2 * (u.pn & 3) + bj; bf16_t* base = qkv + ((size_t)(ti * 8 + head) * S) * HD + wc * 32 + 8 * fq;
#pragma unroll
                for (int ai = 0; ai < 2; ++ai)
#pragma unroll
                    for (int m = 0; m < 4; ++m) { const f32x4 v0 = acc[ai][bj][m][0] * sc, v1 = acc[ai][bj][m][1] * sc;
                        u32x4 w; w.x = cvt_pk_bf16(v0[0], v0[1]); w.y = cvt_pk_bf16(v0[2], v0[3]); w.z = cvt_pk_bf16(v1[0], v1[1]); w.w = cvt_pk_bf16(v1[2], v1[3]);
                        *(u32x4*)(base + (size_t)(row0 + ai * HALF + m * 16) * HD) = w; } }
            if (ti == 1) {
#pragma unroll
                for (int bj = 0; bj < 2; ++bj)
#pragma unroll
                    for (int n = 0; n < 2; ++n) { f32x4 s = acc[0][bj][0][n];
#pragma unroll
                        for (int ai = 0; ai < 2; ++ai)
#pragma unroll
                            for (int m = 0; m < 4; ++m) if (ai + m) s += acc[ai][bj][m][n];
#pragma unroll
                        for (int e = 0; e < 4; ++e) { float v = s[e]; v += __shfl_xor(v, 1); v += __shfl_xor(v, 2); v += __shfl_xor(v, 4); v += __shfl_xor(v, 8);
                            if (fr == 0) atomicAdd(km + ((size_t)(2 * (u.pn & 3) + bj) * 32 + u.pm) * HD + wc * 32 + 8 * fq + 4 * n + e, v); } }
            }
        } else {
            const int gi = (u.pn - 24) >> 3, colt = ((u.pn - 24) & 7) * BM;
            bf16_t* base = sig + (size_t)gi * S * D + colt + wc * 32 + 8 * fq;
#pragma unroll
            for (int ai = 0; ai < 2; ++ai)
#pragma unroll
                for (int m = 0; m < 4; ++m) { bf16_t* rowp = base + (size_t)(row0 + ai * HALF + m * 16) * D;
#pragma unroll
                    for (int bj = 0; bj < 2; ++bj) { const f32x4 v0 = acc[ai][bj][m][0], v1 = acc[ai][bj][m][1];
                        u32x4 w; w.x = cvt_pk_bf16(sigmoidf_fast(v0[0]), sigmoidf_fast(v0[1])); w.y = cvt_pk_bf16(sigmoidf_fast(v0[2]), sigmoidf_fast(v0[3]));
                        w.z = cvt_pk_bf16(sigmoidf_fast(v1[0]), sigmoidf_fast(v1[1])); w.w = cvt_pk_bf16(sigmoidf_fast(v1[2]), sigmoidf_fast(v1[3]));
                        *(u32x4*)(rowp + bj * HALF) = w; } }
        }
    }
};
struct EpiProj {
    static constexpr bool PERM = true, AFTER_DRAIN = false, TWO_SEG = true;
    const bf16_t* sig; bf16_t* merged;
    __device__ __forceinline__ void operator()(f32x4 (&acc)[2][2][4][2], const Unit& u, int wr, int wc, int fr, int fq) const {
        const int row0 = u.pm * BM + wr * 64 + fr, col0 = u.pn * BM + wc * 32 + 8 * fq;
#pragma unroll
        for (int ai = 0; ai < 2; ++ai)
#pragma unroll
            for (int m = 0; m < 4; ++m) { const size_t off = (size_t)(row0 + ai * HALF + m * 16) * D + col0;
#pragma unroll
                for (int bj = 0; bj < 2; ++bj) {
                    float fb[8]; unpack8(*(const u32x4*)(sig + (size_t)S * D + off + bj * HALF), fb);
#pragma unroll
                    for (int e = 0; e < 8; ++e) fb[e] = fmaxf(fb[e], 1e-30f);
                    if (u.seg == 0) { float fa[8]; unpack8(*(const u32x4*)(sig + off + bj * HALF), fa);
#pragma unroll
                        for (int e = 0; e < 4; ++e) { acc[ai][bj][m][0][e] *= fa[e] * __builtin_amdgcn_rcpf(fb[e]); acc[ai][bj][m][1][e] *= fa[4 + e] * __builtin_amdgcn_rcpf(fb[4 + e]); } }
                    else { const f32x4 v0 = acc[ai][bj][m][0], v1 = acc[ai][bj][m][1];
                        u32x4 w; w.x = cvt_pk_bf16(v0[0] * fb[0], v0[1] * fb[1]); w.y = cvt_pk_bf16(v0[2] * fb[2], v0[3] * fb[3]); w.z = cvt_pk_bf16(v1[0] * fb[4], v1[1] * fb[5]); w.w = cvt_pk_bf16(v1[2] * fb[6], v1[3] * fb[7]);
                        *(u32x4*)(merged + off + bj * HALF) = w; } }
                asm volatile("" ::: "memory"); }
    }
};
struct EpiRes {
    static constexpr bool PERM = false, AFTER_DRAIN = false, TWO_SEG = false;
    const float* x; const float* g; float* out; bf16_t* xg; unsigned long long* ssq;
    __device__ __forceinline__ void operator()(const f32x4 (&acc)[2][2][4][2], const Unit& u, int wr, int wc, int fr, int fq) const {
        const int row0 = u.pm * BM + wr * 64 + fr, col0 = u.pn * BM + wc * 32 + 4 * fq;
        f32x4 gv[2][2];
#pragma unroll
        for (int bj = 0; bj < 2; ++bj)
#pragma unroll
            for (int n = 0; n < 2; ++n) gv[bj][n] = g ? *(const f32x4*)(g + col0 + bj * HALF + n * 16) : (f32x4){1.f, 1.f, 1.f, 1.f};
#pragma unroll
        for (int ai = 0; ai < 2; ++ai)
#pragma unroll
            for (int m = 0; m < 4; ++m) { const int row = row0 + ai * HALF + m * 16; const size_t off = (size_t)row * D + col0; float ss = 0.f;
#pragma unroll
                for (int bj = 0; bj < 2; ++bj)
#pragma unroll
                    for (int n = 0; n < 2; ++n) { const size_t o = off + bj * HALF + n * 16; const f32x4 y = *(const f32x4*)(x + o) + acc[ai][bj][m][n]; *(f32x4*)(out + o) = y;
                        ss += (y[0] * y[0] + y[1] * y[1]) + (y[2] * y[2] + y[3] * y[3]);
                        if (g) { const f32x4 z = y * gv[bj][n]; u32x2 w; w.x = cvt_pk_bf16(z[0], z[1]); w.y = cvt_pk_bf16(z[2], z[3]); *(u32x2*)(xg + o) = w; } }
                ss += __shfl_xor(ss, 16); ss += __shfl_xor(ss, 32);
                if (fq == 0) atomicAdd(ssq + row, (unsigned long long)((double)ss * FIX));
                asm volatile("" ::: "memory"); }
    }
};
struct EpiUp {
    static constexpr bool PERM = true, AFTER_DRAIN = false, TWO_SEG = false;
    const unsigned long long* ssq; bf16_t* h;
    __device__ __forceinline__ void operator()(const f32x4 (&acc)[2][2][4][2], const Unit& u, int wr, int wc, int fr, int fq) const {
        const int row0 = u.pm * BM + wr * 64 + fr, col0 = u.pn * BM + wc * 32 + 8 * fq;
#pragma unroll
        for (int ai = 0; ai < 2; ++ai)
#pragma unroll
            for (int m = 0; m < 4; ++m) { const int row = row0 + ai * HALF + m * 16;
                const float r2 = 1.0f / ((float)((double)ssq[row] * (1.0 / FIX)) * (1.0f / D) + EPS);
#pragma unroll
                for (int bj = 0; bj < 2; ++bj) { f32x4 v0 = acc[ai][bj][m][0], v1 = acc[ai][bj][m][1];
#pragma unroll
                    for (int e = 0; e < 4; ++e) { const float a = fmaxf(v0[e], 0.f), b = fmaxf(v1[e], 0.f); v0[e] = a * a * r2; v1[e] = b * b * r2; }
                    u32x4 w; w.x = cvt_pk_bf16(v0[0], v0[1]); w.y = cvt_pk_bf16(v0[2], v0[3]); w.z = cvt_pk_bf16(v1[0], v1[1]); w.w = cvt_pk_bf16(v1[2], v1[3]);
                    *(u32x4*)(h + (size_t)row * FF + col0 + bj * HALF) = w; } }
    }
};
struct TwoSegOrder {
    StaticOrder so;
    __host__ __device__ bool next(int i, Unit& u) const { if (!so.next(i >> 1, u)) return false; u.seg = i & 1; return true; }
    __device__ __forceinline__ void a_ready(const Unit&) const {}
    __device__ __forceinline__ void done(const Unit&) const {}
};

template <class Epi, class Sched, bool ALIGN_EPI = false, bool SP2 = false>
__device__ __forceinline__ void gemm_phase(PG8_LAS unsigned char* lds, const Gemm g, const Sched& S, const Epi& E) {
    const int tid = threadIdx.x, wid = __builtin_amdgcn_readfirstlane(tid >> 6), lane = tid & 63, wr = wid >> 2, wc = wid & 3, fr = lane & 15, fq = lane >> 4;
    const int K = g.K, nt = K / BK;
    unsigned voffA[2], voffB[2];
#pragma unroll
    for (int i = 0; i < 2; ++i) { int R, C; stage_rc(tid * 16 + i * 8192, R, C); const int Rb = Epi::PERM ? ((R & ~31) + perm32(R & 31)) : R;
        voffA[i] = (unsigned)(R * K + C) * 2u; voffB[i] = (unsigned)(Rb * K + C) * 2u; }
    const size_t kstep = (size_t)(BK * 2);
    const size_t hstep = (size_t)HALF * K * 2;
    const size_t tstep = 2 * hstep;
    const unsigned ldsw = (unsigned)wid * 1024u;
    const int aoff = lds_byte(wr * 64 + fr, fq * 8), boff = lds_byte(wc * 32 + fr, fq * 8);
#define PG8_SA(b, h) (((b) * 2 + (h)) * HTB)
#define PG8_SB(b, h) ((4 + (b) * 2 + (h)) * HTB)
#define PG8_STAGE(bufoff, gbase, voff) do { _Pragma("unroll") for (int _i = 0; _i < 2; ++_i) \
        __builtin_amdgcn_global_load_lds((const unsigned*)((const char*)(gbase) + (voff)[_i]), (PG8_LAS unsigned*)(lds + (bufoff) + ldsw + _i * 8192), 16, 0, 0); } while (0)
#define PG8_LDA(dst, b, h) do { _Pragma("unroll") for (int m = 0; m < 4; ++m) _Pragma("unroll") for (int k = 0; k < 2; ++k) dst[m][k] = *(const PG8_LAS bf16x8*)(lds + PG8_SA(b, h) + aoff + m * 2048 + k * 1024); } while (0)
#define PG8_LDB(dst, b, h) do { _Pragma("unroll") for (int n = 0; n < 2; ++n) _Pragma("unroll") for (int k = 0; k < 2; ++k) dst[n][k] = *(const PG8_LAS bf16x8*)(lds + PG8_SB(b, h) + boff + n * 2048 + k * 1024); } while (0)
#define PG8_MMA(ai, bj, At, Bt) do { __builtin_amdgcn_s_setprio(1); _Pragma("unroll") for (int m = 0; m < 4; ++m) _Pragma("unroll") for (int n = 0; n < 2; ++n) _Pragma("unroll") for (int k = 0; k < 2; ++k) \
        acc[ai][bj][m][n] = __builtin_amdgcn_mfma_f32_16x16x32_bf16(Bt[n][k], At[m][k], acc[ai][bj][m][n], 0, 0, 0); __builtin_amdgcn_s_setprio(0); } while (0)
#define PG8_WAIT_V(n) asm volatile("s_waitcnt vmcnt(" #n ")" ::: "memory")
#define PG8_WAIT_L(n) asm volatile("s_waitcnt lgkmcnt(" #n ")" ::: "memory")
#define PG8_BAR __builtin_amdgcn_s_barrier()
#define PG8_SCHED __builtin_amdgcn_sched_barrier(0)
    Unit cur, nxt; int ui = 0;
    if (!S.next(0, cur)) return;
    f32x4 acc[2][2][4][2];
#pragma unroll
    for (int a = 0; a < 2; ++a)
#pragma unroll
        for (int b = 0; b < 2; ++b)
#pragma unroll
            for (int m = 0; m < 4; ++m)
#pragma unroll
                for (int n = 0; n < 2; ++n) acc[a][b][m][n] = (f32x4){0.f, 0.f, 0.f, 0.f};
    bf16x8 At[4][2], B0[2][2], B1[2][2];
    const char* cA = (const char*)(cur.seg ? g.A1 : g.A0) + (size_t)cur.pm * tstep; const char* cB = (const char*)(cur.seg ? g.B1 : g.B0) + (size_t)cur.pn * tstep;
    S.a_ready(cur);
    if constexpr (SP2) {
        PG8_STAGE(PG8_SB(0, 0), cB, voffB); PG8_STAGE(PG8_SB(0, 1), cB + hstep, voffB); PG8_STAGE(PG8_SA(0, 0), cA, voffA); PG8_STAGE(PG8_SA(0, 1), cA + hstep, voffA);
        if (wr == 1) PG8_BAR;
        PG8_WAIT_V(2); PG8_BAR;
        PG8_STAGE(PG8_SB(1, 0), cB + kstep, voffB); PG8_STAGE(PG8_SA(1, 0), cA + kstep, voffA); PG8_STAGE(PG8_SB(1, 1), cB + hstep + kstep, voffB);
        PG8_WAIT_V(6); PG8_BAR;
    } else {
        PG8_STAGE(PG8_SB(0, 0), cB, voffB); PG8_STAGE(PG8_SA(0, 0), cA, voffA); PG8_STAGE(PG8_SB(0, 1), cB + hstep, voffB); PG8_STAGE(PG8_SA(0, 1), cA + hstep, voffA);
        if (wr == 1) PG8_BAR;
        PG8_WAIT_V(4); PG8_BAR;
        PG8_STAGE(PG8_SB(1, 0), cB + kstep, voffB); PG8_STAGE(PG8_SA(1, 0), cA + kstep, voffA); PG8_STAGE(PG8_SB(1, 1), cB + hstep + kstep, voffB);
        PG8_WAIT_V(6); PG8_BAR;
    }
    for (;;) {
        const bool has_next = S.next(ui + 1, nxt);
        const char* nA = has_next ? (const char*)(nxt.seg ? g.A1 : g.A0) + (size_t)nxt.pm * tstep : cA; const char* nB = has_next ? (const char*)(nxt.seg ? g.B1 : g.B0) + (size_t)nxt.pn * tstep : cB;
        for (int t = 0; t < nt; t += 2) {
            const bool last = (t == nt - 2);
            const char* a1 = cA + (size_t)(t + 1) * kstep;
            const char* a2 = last ? nA : cA + (size_t)(t + 2) * kstep; const char* b2 = last ? nB : cB + (size_t)(t + 2) * kstep;
            const char* a3 = a2 + kstep; const char* b3 = b2 + kstep;
            if (last && has_next) S.a_ready(nxt);
            if constexpr (SP2) {
            PG8_LDB(B0, 0, 0); PG8_LDB(B1, 0, 1); PG8_SCHED; PG8_LDA(At, 0, 0); PG8_STAGE(PG8_SA(1, 1), a1 + hstep, voffA);
            PG8_WAIT_V(8); PG8_WAIT_L(0); PG8_BAR; PG8_MMA(0, 0, At, B0); PG8_MMA(0, 1, At, B1); PG8_BAR; PG8_SCHED;
            PG8_LDA(At, 0, 1); PG8_STAGE(PG8_SB(0, 0), b2, voffB); PG8_STAGE(PG8_SB(0, 1), b2 + hstep, voffB); PG8_STAGE(PG8_SA(0, 0), a2, voffA);
            PG8_WAIT_V(8); PG8_WAIT_L(0); PG8_BAR; PG8_MMA(1, 0, At, B0); PG8_MMA(1, 1, At, B1); PG8_BAR; PG8_SCHED;
            PG8_LDB(B0, 1, 0); PG8_LDB(B1, 1, 1); PG8_SCHED; PG8_LDA(At, 1, 0); PG8_STAGE(PG8_SA(0, 1), a2 + hstep, voffA);
            PG8_WAIT_V(8); PG8_WAIT_L(0); PG8_BAR; PG8_MMA(0, 0, At, B0); PG8_MMA(0, 1, At, B1); PG8_BAR; PG8_SCHED;
            PG8_LDA(At, 1, 1); PG8_STAGE(PG8_SB(1, 0), b3, voffB); PG8_STAGE(PG8_SB(1, 1), b3 + hstep, voffB); PG8_STAGE(PG8_SA(1, 0), a3, voffA);
            PG8_WAIT_V(8); PG8_WAIT_L(0); PG8_BAR; PG8_MMA(1, 0, At, B0); PG8_MMA(1, 1, At, B1); PG8_BAR; PG8_SCHED;
            } else {
            PG8_LDB(B0, 0, 0); PG8_SCHED; PG8_LDA(At, 0, 0); PG8_STAGE(PG8_SA(1, 1), a1 + hstep, voffA);
            PG8_WAIT_L(8); PG8_BAR; PG8_WAIT_L(0); PG8_MMA(0, 0, At, B0); PG8_BAR; PG8_SCHED;
            PG8_LDB(B1, 0, 1); PG8_STAGE(PG8_SB(0, 0), b2, voffB);
            PG8_BAR; PG8_WAIT_L(0); PG8_MMA(0, 1, At, B1); PG8_BAR;
            PG8_LDA(At, 0, 1); PG8_STAGE(PG8_SA(0, 0), a2, voffA);
            PG8_BAR; PG8_WAIT_L(0); PG8_MMA(1, 0, At, B0); PG8_BAR; PG8_SCHED;
            PG8_STAGE(PG8_SB(0, 1), b2 + hstep, voffB);
            PG8_WAIT_V(6); PG8_BAR; PG8_MMA(1, 1, At, B1); PG8_BAR;
            PG8_LDB(B0, 1, 0); PG8_SCHED; PG8_LDA(At, 1, 0); PG8_STAGE(PG8_SA(0, 1), a2 + hstep, voffA);
            PG8_WAIT_L(8); PG8_BAR; PG8_WAIT_L(0); PG8_MMA(0, 0, At, B0); PG8_BAR; PG8_SCHED;
            PG8_LDB(B1, 1, 1); PG8_STAGE(PG8_SB(1, 0), b3, voffB);
            PG8_BAR; PG8_WAIT_L(0); PG8_MMA(0, 1, At, B1); PG8_BAR;
            PG8_LDA(At, 1, 1); PG8_STAGE(PG8_SA(1, 0), a3, voffA);
            PG8_BAR; PG8_WAIT_L(0); PG8_MMA(1, 0, At, B0); PG8_BAR; PG8_SCHED;
            PG8_STAGE(PG8_SB(1, 1), b3 + hstep, voffB);
            PG8_WAIT_V(6); PG8_BAR; PG8_MMA(1, 1, At, B1); PG8_BAR;
            }
        }
        if constexpr (ALIGN_EPI) { if (wr == 0) PG8_BAR; }
        if constexpr (!Epi::AFTER_DRAIN) { E(acc, cur, wr, wc, fr, fq); S.done(cur); }
        if (!has_next) break;
        if (!(Epi::TWO_SEG && cur.seg == 0))
#pragma unroll
        for (int a = 0; a < 2; ++a)
#pragma unroll
            for (int b = 0; b < 2; ++b)
#pragma unroll
                for (int m = 0; m < 4; ++m)
#pragma unroll
                    for (int n = 0; n < 2; ++n) acc[a][b][m][n] = (f32x4){0.f, 0.f, 0.f, 0.f};
        cur = nxt; cA = nA; cB = nB; ++ui;
        if constexpr (ALIGN_EPI) { if (wr == 1) PG8_BAR; }
    }
    PG8_WAIT_V(0);
    if constexpr (!ALIGN_EPI) { if (wr == 0) PG8_BAR; }
    PG8_BAR;
    if constexpr (Epi::AFTER_DRAIN) { E.fused(acc, cur, wr, wc, fr, fq, lds, wid, lane); S.done(cur); }
#undef PG8_SA
#undef PG8_SB
#undef PG8_STAGE
#undef PG8_LDA
#undef PG8_LDB
#undef PG8_MMA
#undef PG8_WAIT_V
#undef PG8_WAIT_L
#undef PG8_BAR
#undef PG8_SCHED
}
}

#define GAS __attribute__((address_space(1)))
#define LAS __attribute__((address_space(3)))
typedef unsigned short bf16;
typedef unsigned v4u __attribute__((ext_vector_type(4)));
typedef float f32x4 __attribute__((ext_vector_type(4)));
typedef short bf16x8 __attribute__((ext_vector_type(8)));
typedef GAS unsigned gu32;
typedef GAS unsigned long long gu64;
#define RLX_AGENT __ATOMIC_RELAXED, __HIP_MEMORY_SCOPE_AGENT
#define LDS_WAIT() asm volatile("s_waitcnt lgkmcnt(0)" ::: "memory")
#define VM_WAIT() asm volatile("s_waitcnt vmcnt(0)" ::: "memory")
__device__ __forceinline__ unsigned long long rt() { return __builtin_amdgcn_s_memrealtime(); }
__device__ __forceinline__ unsigned f2bf(float f) { unsigned u = __builtin_bit_cast(unsigned, f); return (u + 0x7fffu + ((u >> 16) & 1u)) >> 16; }
__device__ __forceinline__ unsigned pk2(float lo, float hi) { return f2bf(lo) | (f2bf(hi) << 16); }

#define XB_TMO      128
#define XB_XCNT(j)  (256  + 64 * (j))
#define XB_XSUB(j)  (1280 + 64 * (j))
#define XB_XGEN(j)  (2304 + 64 * (j))
#define XB_TOP      3328
#define XB_TOPGEN   3392
#define XCD_BAR_WORDS 3456
#define XB_SPIN_CAP (1u << 18)

__device__ __forceinline__ unsigned xb_ld(unsigned* p)              { return __hip_atomic_load(p, __ATOMIC_RELAXED, __HIP_MEMORY_SCOPE_AGENT); }
__device__ __forceinline__ unsigned xb_add(unsigned* p, unsigned v) { return __hip_atomic_fetch_add(p, v, __ATOMIC_RELAXED, __HIP_MEMORY_SCOPE_AGENT); }
__device__ __forceinline__ unsigned xb_xcc_id() { return (unsigned)__builtin_amdgcn_s_getreg((3 << 11) | 20) & 0xFu; }
#define XB_SPIN(cond, bar) do { unsigned _sp = 0; while (cond) { __builtin_amdgcn_s_sleep(1); \
    if ((++_sp & 255u) == 0u) { if (xb_ld(&(bar)[XB_TMO])) break; if (_sp > XB_SPIN_CAP) { atomicAdd(&(bar)[XB_TMO], 1u); break; } } } } while (0)

struct XcdBarrier {
    unsigned* bar; unsigned x;
    volatile LAS unsigned* st;
};

__device__ __forceinline__ XcdBarrier xcd_barrier_post(unsigned* bar, volatile LAS unsigned* st) {
    XcdBarrier b; b.bar = bar; b.x = xb_xcc_id(); b.st = st;
    if (threadIdx.x == 0) (void)xb_add(&bar[XB_XCNT(b.x)], 1u);
    return b;
}
__device__ __forceinline__ void xcd_barrier_complete(unsigned* bar, unsigned x, unsigned& nloc, unsigned& nx) {
    const unsigned G = gridDim.x * gridDim.y * gridDim.z;
    unsigned sum, cnt, mine, sp = 0u;
    for (;;) {
        sum = 0u; cnt = 0u; mine = 0u;
#pragma unroll
        for (unsigned j = 0; j < 16; ++j) { const unsigned c = xb_ld(&bar[XB_XCNT(j)]); sum += c; cnt += (c > 0u) ? 1u : 0u; mine = (j == x) ? c : mine; }
        if (sum == G) break;
        __builtin_amdgcn_s_sleep(1);
        if ((++sp & 255u) == 0u) { if (xb_ld(&bar[XB_TMO])) break; if (sp > XB_SPIN_CAP) { atomicAdd(&bar[XB_TMO], 1u); break; } }
    }
    nloc = mine > 0u ? mine : 1u; nx = cnt > 0u ? cnt : 1u;
}

__device__ __forceinline__ void xcd_barrier(const XcdBarrier& b) {
    asm volatile("s_waitcnt vmcnt(0)" ::: "memory");
    __syncthreads();
    if (threadIdx.x == 0) {
        unsigned* bar = b.bar;
        __builtin_amdgcn_s_waitcnt(0);
        unsigned nloc = b.st[0], nx = b.st[1];
        if (nloc == 0u) { xcd_barrier_complete(bar, b.x, nloc, nx); b.st[0] = nloc; b.st[1] = nx; }
        const unsigned old = xb_add(&bar[XB_XSUB(b.x)], 1u);
        const unsigned gen = old / nloc;
        if (old + 1u == (gen + 1u) * nloc) {
            __builtin_amdgcn_fence(__ATOMIC_RELEASE, "agent");
            asm volatile("s_waitcnt vmcnt(0)" ::: "memory");
            const unsigned og = xb_add(&bar[XB_TOP], 1u);
            const unsigned tg = og / nx;
            if (og + 1u == (tg + 1u) * nx) xb_add(&bar[XB_TOPGEN], 1u);
            else XB_SPIN(xb_ld(&bar[XB_TOPGEN]) == tg, bar);
            __builtin_amdgcn_fence(__ATOMIC_ACQUIRE, "agent");
            xb_add(&bar[XB_XGEN(b.x)], 1u);
            asm volatile("s_waitcnt vmcnt(0)" ::: "memory");
        } else {
            XB_SPIN(xb_ld(&bar[XB_XGEN(b.x)]) == gen, bar);
            __builtin_amdgcn_fence(__ATOMIC_ACQUIRE, "agent");
            asm volatile("s_waitcnt vmcnt(0)" ::: "memory");
        }
    }
    __syncthreads();
}

namespace att {
#define ALDS __attribute__((address_space(3)))
typedef ALDS char* lptr; typedef const ALDS char* clptr;
typedef short bf16x8 __attribute__((ext_vector_type(8)));
typedef short s16x4 __attribute__((ext_vector_type(4)));
typedef float f32x16 __attribute__((ext_vector_type(16)));
typedef float f32x4 __attribute__((ext_vector_type(4)));
typedef unsigned u32x4 __attribute__((ext_vector_type(4)));
constexpr int NW = 8, QBLK = 32, KVBLK = 64, QB = 256, DH = 128, LDO = 1024;
constexpr int SHM_V = KVBLK * DH * 2, SHM_K = KVBLK * DH * 2;
constexpr int OFF_WS = 2 * SHM_V + 2 * SHM_K, OFF_BIAS = OFF_WS + NW * 64 * 4, ATT_LDS_BYTES = OFF_BIAS + 2 * 256;
constexpr float THR2 = 11.5f;
#define KSWZ(row, colB) ((row) * 256 + ((colB) ^ (((row) & 7) << 4)))
#define SBAR() __builtin_amdgcn_sched_barrier(0)
__device__ __forceinline__ int v_st(int k, int c) { const int kk = (k & ~0xC) | ((k & 4) << 1) | ((k & 8) >> 1); return ((kk >> 3) * 4 + (c >> 5)) * 512 + ((kk & 7) * 32 + (c & 31)) * 2; }
__device__ __forceinline__ int v_rd_base(int lane) { return ((lane & 3) << 3) | (((lane >> 2) & 3) << 6) | (((lane >> 4) & 1) << 5) | (((lane >> 5) & 1) << 8); }
constexpr int v_rd_off(int d0, int ks, int half) { return d0 * 512 + ks * 4096 + half * 2048; }
__device__ __forceinline__ int crow(int r, int hi) { return (r & 3) + 8 * (r >> 2) + 4 * hi; }
typedef float f32x2_t __attribute__((ext_vector_type(2))); typedef __bf16 bf16x2_t __attribute__((ext_vector_type(2)));
__device__ __forceinline__ unsigned cvtpk(float lo, float hi) { f32x2_t v = {lo, hi}; bf16x2_t b = __builtin_convertvector(v, bf16x2_t); return __builtin_bit_cast(unsigned, b); }
__device__ __forceinline__ bf16x8 ld16(const void* ubase, unsigned voff) { return *reinterpret_cast<const bf16x8*>((const char*)ubase + voff); }
__device__ __forceinline__ void mask_tile(f32x16& p0, f32x16& p1, int dq) {
    const float NEG = -__builtin_inff();
#pragma unroll
    for (int r = 0; r < 16; ++r) { const int c = (r & 3) + 8 * (r >> 2); if (c > dq) p0[r] = NEG; if (c + 32 > dq) p1[r] = NEG; }
}
__device__ __forceinline__ void partialSM(f32x16& p0, f32x16& p1, float& m_reg, float& alpha, bool off) {
    float pmax = p0[0];
#pragma unroll
    for (int r = 1; r < 16; ++r) pmax = fmaxf(pmax, p0[r]);
#pragma unroll
    for (int r = 0; r < 16; ++r) pmax = fmaxf(pmax, p1[r]);
    { auto rr = __builtin_amdgcn_permlane32_swap(__float_as_uint(pmax), __float_as_uint(pmax), false, false);
      pmax = fmaxf(__uint_as_float(rr[0]), __uint_as_float(rr[1])); }
    if (off) pmax = -__builtin_inff();
    float mn;
    if (__builtin_expect(__all((pmax - m_reg) <= THR2), 1)) { mn = m_reg; alpha = 1.f; }
    else { mn = fmaxf(m_reg, pmax); alpha = __builtin_amdgcn_exp2f(m_reg - mn); m_reg = mn; }
    const float mnL = off ? __builtin_inff() : mn;
#pragma unroll
    for (int r = 0; r < 16; ++r) p0[r] = p0[r] - mnL;
#pragma unroll
    for (int r = 0; r < 16; ++r) p1[r] = p1[r] - mnL;
#pragma unroll
    for (int r = 0; r < 16; ++r) p0[r] = __builtin_amdgcn_exp2f(p0[r]);
}
__device__ __forceinline__ void finishSM(f32x16& p0, f32x16& p1, float alpha, float& l_reg, bf16x8& pa0, bf16x8& pa1, bf16x8& pa2, bf16x8& pa3) {
#pragma unroll
    for (int r = 0; r < 16; ++r) p1[r] = __builtin_amdgcn_exp2f(p1[r]);
    float ps = 0;
#pragma unroll
    for (int r = 0; r < 16; ++r) ps += p0[r];
#pragma unroll
    for (int r = 0; r < 16; ++r) ps += p1[r];
    { auto rr = __builtin_amdgcn_permlane32_swap(__float_as_uint(ps), __float_as_uint(ps), false, false);
      ps = __uint_as_float(rr[0]) + __uint_as_float(rr[1]); }
    l_reg = l_reg * alpha + ps;
#define PK4(P, B_, OUT) do { unsigned a0 = cvtpk(P[B_+0], P[B_+1]), a1 = cvtpk(P[B_+2], P[B_+3]);                          \
        unsigned b0 = cvtpk(P[B_+4], P[B_+5]), b1 = cvtpk(P[B_+6], P[B_+7]);                                             \
        auto r0 = __builtin_amdgcn_permlane32_swap(a0, b0, false, false); auto r1 = __builtin_amdgcn_permlane32_swap(a1, b1, false, false); \
        u32x4 w = {r0[0], r1[0], r0[1], r1[1]}; OUT = *reinterpret_cast<bf16x8*>(&w); } while (0)
    PK4(p0, 0, pa0); PK4(p0, 8, pa1); PK4(p1, 0, pa2); PK4(p1, 8, pa3);
#undef PK4
}
template <int KB>
__device__ __forceinline__ void qkt(f32x16& p0, f32x16& p1, clptr K_lds, clptr bias_lds, int r32, int hi, const bf16x8* qr) {
    const ALDS f32x4* bp = (const ALDS f32x4*)(bias_lds + KB * 256 + hi * 16);
    { const f32x4 a = bp[0], b = bp[2], c = bp[4], d = bp[6], e = bp[8], f = bp[10], g = bp[12], h = bp[14];
      p0 = (f32x16){a[0], a[1], a[2], a[3], b[0], b[1], b[2], b[3], c[0], c[1], c[2], c[3], d[0], d[1], d[2], d[3]};
      p1 = (f32x16){e[0], e[1], e[2], e[3], f[0], f[1], f[2], f[3], g[0], g[1], g[2], g[3], h[0], h[1], h[2], h[3]}; }
    clptr kb[4];
#pragma unroll
    for (int dd = 0; dd < 4; ++dd) kb[dd] = K_lds + KB * SHM_K + KSWZ(r32, (dd * 16 + hi * 8) * 2);
#pragma unroll
    for (int d0 = 0; d0 < 8; ++d0) { clptr a = kb[d0 & 3] + (d0 >> 2) * 128;
        bf16x8 b0 = *(const ALDS bf16x8*)(a);
        bf16x8 b1 = *(const ALDS bf16x8*)(a + 32 * 256);
        p0 = __builtin_amdgcn_mfma_f32_32x32x16_bf16(b0, qr[d0], p0, 0, 0, 0);
        p1 = __builtin_amdgcn_mfma_f32_32x32x16_bf16(b1, qr[d0], p1, 0, 0, 0);
        if (d0 == 3) SBAR(); }
}
template <int VB>
__device__ __forceinline__ void pv_tile(f32x16* o, int vb0, bf16x8 pa0, bf16x8 pa1, bf16x8 pa2, bf16x8 pa3) {
#define TRRD(dst, off) asm volatile("ds_read_b64_tr_b16 %0, %1 offset:%2" : "=&v"(dst) : "v"(vb0), "i"(off) : "memory")
#define PV_D0(d0) do { s16x4 l0, l1, l2, l3, h0, h1, h2, h3; constexpr int b_ = VB * SHM_V + v_rd_off(d0, 0, 0); \
        TRRD(l0, b_); TRRD(h0, b_ + 2048); TRRD(l1, b_ + 4096); TRRD(h1, b_ + 6144); TRRD(l2, b_ + 8192); TRRD(h2, b_ + 10240); TRRD(l3, b_ + 12288); TRRD(h3, b_ + 14336); \
        asm volatile("s_waitcnt lgkmcnt(0)" ::: "memory"); SBAR();   \
        o[d0] = __builtin_amdgcn_mfma_f32_32x32x16_bf16(pa0, (bf16x8){l0[0], l0[1], l0[2], l0[3], h0[0], h0[1], h0[2], h0[3]}, o[d0], 0, 0, 0);   \
        o[d0] = __builtin_amdgcn_mfma_f32_32x32x16_bf16(pa1, (bf16x8){l1[0], l1[1], l1[2], l1[3], h1[0], h1[1], h1[2], h1[3]}, o[d0], 0, 0, 0);   \
        o[d0] = __builtin_amdgcn_mfma_f32_32x32x16_bf16(pa2, (bf16x8){l2[0], l2[1], l2[2], l2[3], h2[0], h2[1], h2[2], h2[3]}, o[d0], 0, 0, 0);   \
        o[d0] = __builtin_amdgcn_mfma_f32_32x32x16_bf16(pa3, (bf16x8){l3[0], l3[1], l3[2], l3[3], h3[0], h3[1], h3[2], h3[3]}, o[d0], 0, 0, 0); } while (0)
    PV_D0(0); PV_D0(1); PV_D0(2); PV_D0(3);
#undef PV_D0
#undef TRRD
}
struct BlockRef { int kind, h, P0, j_lo, j_hi; float blin, bref; };
__device__ __forceinline__ const bf16* bq(const unsigned char* ws, const BlockRef& B) { return (const bf16*)(ws + WS_QKV) + (size_t)(B.kind ? 0 : 3) * QKV_T + ((size_t)B.h * S + B.P0) * HD; }
__device__ __forceinline__ const bf16* bk(const unsigned char* ws, const BlockRef& B) { return (const bf16*)(ws + WS_QKV) + (size_t)(B.kind ? 1 : 4) * QKV_T + (size_t)B.h * S * HD; }
__device__ __forceinline__ const bf16* bv(const unsigned char* ws, const BlockRef& B) { return (const bf16*)(ws + WS_QKV) + (size_t)(B.kind ? 2 : 5) * QKV_T + (size_t)B.h * S * HD; }
__device__ __forceinline__ bf16* bo(unsigned char* ws, const BlockRef& B) { return (bf16*)(ws + (B.kind ? WS_AM : WS_AF)) + (size_t)B.P0 * MW + B.h * HD; }
struct Seam { bf16x8 qr[8]; bf16x8 st_v0, st_v1, st_k0, st_k1; float st_b; };
#define VMW() asm volatile("s_waitcnt vmcnt(0)" ::: "memory")
#define VMWN(n) asm volatile("s_waitcnt vmcnt(%0)" :: "i"(n) : "memory")
#define BIASV(B, k0) (tid < 64 ? (((B).kind == 0 ? ((const float*)(ws + WS_CBN))[(size_t)(B).h * S + (k0) + tid] : 0.f) + (B).blin * (float)((k0) + tid) - (B).bref) : 0.f)
#define SLOAD_H(B, k0) do { const char* kb_ = (const char*)bk(ws, B) + (size_t)(k0) * (DH * 2); const char* vb_ = (const char*)bv(ws, B) + (size_t)(k0) * (DH * 2);              \
                            Sm.st_v0 = ld16(vb_, kvoff); Sm.st_v1 = ld16(vb_ + 32 * DH * 2, kvoff); Sm.st_k0 = ld16(kb_, kvoff); Sm.st_k1 = ld16(kb_ + 32 * DH * 2, kvoff); Sm.st_b = BIASV(B, k0); } while (0)
#define SWRITE_HK(bf) do { *(ALDS bf16x8*)(K_lds + (bf) * SHM_K + kws) = Sm.st_k0; *(ALDS bf16x8*)(K_lds + (bf) * SHM_K + kws + 32 * 256) = Sm.st_k1; \
                           if (tid < 64) *(ALDS float*)(B_lds + (bf) * 256 + tid * 4) = Sm.st_b; } while (0)
#define SWRITE_HV(bf) do { *(ALDS bf16x8*)(V_lds + (bf) * SHM_V + vst0) = Sm.st_v0; *(ALDS bf16x8*)(V_lds + (bf) * SHM_V + vst1) = Sm.st_v1; } while (0)
#define SWRITE_H(bf) do { SWRITE_HV(bf); SWRITE_HK(bf); } while (0)
__device__ __forceinline__ void attn_block(unsigned char* ws, const BlockRef& cur, lptr lds, Seam& Sm) {
    const int tid = threadIdx.x, wid = __builtin_amdgcn_readfirstlane(tid >> 6), lane = tid & 63, r32 = lane & 31, hi = lane >> 5;
    const int j_lo = cur.j_lo, NT = cur.j_hi - cur.j_lo;
    const int qlo = cur.P0 + wid * QBLK, qm = qlo + r32 - 4 * hi;
    lptr V_lds = lds; lptr K_lds = lds + 2 * SHM_V; lptr B_lds = lds + OFF_BIAS;
    ALDS float* wsf = (ALDS float*)(lds + OFF_WS) + wid * 64; ALDS float* li_l = wsf; ALDS float* al_l = wsf + 32;
    const int sr = tid >> 4, sc = (tid & 15) * 8, vst0 = v_st(sr, sc), vst1 = v_st(32 + sr, sc), kws = KSWZ(sr, sc * 2);
    const int vb0 = (int)(unsigned)(size_t)V_lds + v_rd_base(lane);
    const unsigned kvoff = (unsigned)(sr * DH + sc) * 2u, qoff = (unsigned)((wid * QBLK + r32) * DH + hi * 8) * 2u;
#pragma unroll
    for (int d0 = 0; d0 < 8; ++d0) Sm.qr[d0] = ld16((const char*)bq(ws, cur) + d0 * 32, qoff);
    SLOAD_H(cur, j_lo * KVBLK);
    const unsigned smask = cur.kind ? ((const unsigned*)(ws + WS_SEL))[(size_t)cur.h * S + cur.P0 + wid * QBLK + r32] : 0xffffffffu;
    VMW(); SWRITE_H(0);
    __syncthreads();
    float m_reg = -1e30f, l_reg = 0; f32x16 o[4] = {};
#define RESC(a) do { if (__any((a) < 1.f)) { if (hi == 0) al_l[r32] = (a); asm volatile("s_waitcnt lgkmcnt(0)" ::: "memory");              \
                     _Pragma("unroll") for (int d_ = 0; d_ < 4; ++d_) _Pragma("unroll") for (int r = 0; r < 16; ++r) o[d_][r] *= al_l[crow(r, hi)]; } } while (0)
#define KBASE(t) ((j_lo + (t)) * KVBLK)
#define OFFT(t) (!((smask >> (KBASE(t) >> 8)) & 1u))
#define MASKT(P0_, P1_, t) do { const int kb_ = KBASE(t); if (kb_ + KVBLK - 1 > qlo) mask_tile(P0_, P1_, qm - kb_); } while (0)
#define TILE(t, BUF) do { f32x16 p0, p1; float al; bf16x8 pa0, pa1, pa2, pa3;                                              \
        if ((t) + 1 < NT) { SLOAD_H(cur, KBASE((t) + 1)); } SBAR();                                                      \
        qkt<BUF>(p0, p1, K_lds, B_lds, r32, hi, Sm.qr);                                                                   \
        MASKT(p0, p1, (t)); partialSM(p0, p1, m_reg, al, OFFT(t)); RESC(al);                                               \
        finishSM(p0, p1, al, l_reg, pa0, pa1, pa2, pa3); SBAR();                                                          \
        pv_tile<BUF>(o, vb0, pa0, pa1, pa2, pa3);                                                                          \
        if ((t) + 1 < NT) { VMW(); SWRITE_H((BUF) ^ 1); }                                                                  \
        __syncthreads(); } while (0)
    int t = 0;
    for (; t + 1 < NT; t += 2) { TILE(t, 0); TILE(t + 1, 1); }
    if (t < NT) TILE(t, 0);
    if (hi == 0) li_l[r32] = l_reg; asm volatile("s_waitcnt lgkmcnt(0)" ::: "memory");
    float rli[16];
#pragma unroll
    for (int r = 0; r < 16; ++r) rli[r] = __builtin_amdgcn_rcpf(li_l[crow(r, hi)]);
    const unsigned ooff = (unsigned)((wid * QBLK + 4 * hi) * LDO + r32) * 2u;
#pragma unroll
    for (int r = 0; r < 16; ++r) { const int cr = (r & 3) + 8 * (r >> 2);
#pragma unroll
        for (int d0 = 0; d0 < 4; ++d0) { const float v = o[d0][r] * rli[r]; const float vn = __shfl_xor(v, 1);
            if ((r32 & 1) == 0) *(unsigned*)((char*)bo(ws, cur) + (cr * LDO + d0 * 32) * 2 + ooff) = cvtpk(v, vn); } }
    asm volatile("s_waitcnt lgkmcnt(0)" ::: "memory");
#undef RESC
#undef KBASE
#undef OFFT
#undef MASKT
#undef TILE
}
#undef VMW
#undef VMWN
#undef BIASV
#undef SLOAD_H
#undef SWRITE_HK
#undef SWRITE_HV
#undef SWRITE_H
#undef KSWZ
#undef SBAR
#undef ALDS
}
constexpr int NWAVES = 8;
constexpr int RING_OFF = 0, RING_BYTES = 131072;
constexpr int LDSCTL_OFF = RING_BYTES, MISC_OFF = LDSCTL_OFF + 320;
constexpr int LDS_BYTES = 147456;
#ifndef MK_N_LAUNCHES
#define MK_N_LAUNCHES 1
#endif
constexpr int N_PHASES = 9;

struct Args { const float* in[11]; float* out; unsigned char* ws; int ph_lo, ph_hi, li, pad; };
struct Frame {
    LAS unsigned char* lds; volatile LAS unsigned* MISC; gu32* ctl;
    int tid, lane, wave, vcu, G;
    const Args* a;
};
#define F_IN(i)   (F.a->in[i])
#define F_x       F_IN(0)
#define F_g_mix   F_IN(1)
#define F_w_in    F_IN(2)
#define F_b_forget F_IN(3)
#define F_w_pa    F_IN(4)
#define F_w_pb    F_IN(5)
#define F_w_out   F_IN(6)
#define F_g_mlp   F_IN(7)
#define F_w_up    F_IN(8)
#define F_w_dn    F_IN(9)
#define F_g_fin   F_IN(10)
#define F_out     (F.a->out)
#define F_WS(off) (F.a->ws + (off))
#define F_WIN  ((bf16*)F_WS(WS_WIN))
#define F_WA   ((bf16*)F_WS(WS_WA))
#define F_WB   ((bf16*)F_WS(WS_WB))
#define F_WOUT ((bf16*)F_WS(WS_WOUT))
#define F_WUP  ((bf16*)F_WS(WS_WUP))
#define F_WDN  ((bf16*)F_WS(WS_WDN))
#define F_XN   ((bf16*)F_WS(WS_XN))
#define F_MERGED ((bf16*)F_WS(WS_MERGED))
#define F_QKV  ((bf16*)F_WS(WS_QKV))
#define F_SIG  ((bf16*)F_WS(WS_SIG))
#define F_AM   ((bf16*)F_WS(WS_AM))
#define F_AF   ((bf16*)F_WS(WS_AF))
#define F_X1G  ((bf16*)F_WS(WS_X1G))
#define F_HB   ((bf16*)F_WS(WS_H))
#define F_FLOG ((float*)F_WS(WS_FLOG))
#define F_CBN  ((float*)F_WS(WS_CBN))
#define F_SEL  ((unsigned*)F_WS(WS_SEL))
#define F_SSQ1 ((unsigned long long*)F_WS(CT_SSQ1))
#define F_SSQ2 ((unsigned long long*)F_WS(CT_SSQ2))
#define F_KM   ((float*)F_WS(CT_KMEAN))
__device__ __forceinline__ void p0_transpose_item(const float* W, int K, int Nsrc, int Ndst, int split, int skip, bf16* WT, LAS float* scr, int item, int lane) {
    const int nblk = Ndst / 32, kb = item / nblk, nb = item % nblk, k0 = 64 * kb, n0 = 32 * nb, s0 = n0 >= split ? n0 + skip : n0;
#pragma unroll 8
    for (int i = 0; i < 32; ++i) { const int kk = 2 * i + (lane >> 5); scr[kk * 33 + (lane & 31)] = W[(size_t)(k0 + kk) * Nsrc + s0 + (lane & 31)]; }
    LDS_WAIT(); asm volatile("" ::: "memory");
    const int c = lane & 7;
#pragma unroll
    for (int j = 0; j < 4; ++j) { const int n = (lane >> 3) + 8 * j; const LAS float* s = scr + (8 * c) * 33 + n;
        v4u o; o.x = pk2(s[0 * 33], s[1 * 33]); o.y = pk2(s[2 * 33], s[3 * 33]); o.z = pk2(s[4 * 33], s[5 * 33]); o.w = pk2(s[6 * 33], s[7 * 33]);
        *(GAS v4u*)(WT + (size_t)(n0 + n) * K + k0 + 8 * c) = o; }
    LDS_WAIT(); asm volatile("" ::: "memory");
}
__device__ __forceinline__ void p0_prologue(Frame& F) {
    LAS float* scr = (LAS float*)(F.lds + RING_OFF + F.wave * 16384);
    const int gw = F.vcu * NWAVES + F.wave, NGW = F.G * NWAVES;
    constexpr int I_IN = (D / 64) * (NZ / 32), I_P = (MW / 64) * (D / 32), I_O = (D / 64) * (D / 32), I_U = (D / 64) * (FF / 32), I_D = (FF / 64) * (D / 32);
    constexpr int NITEMS = I_IN + 2 * I_P + I_O + I_U + I_D;
    for (int it = gw; it < NITEMS; it += NGW) {
        int r = it;
        if (r < I_IN) { p0_transpose_item(F_w_in, D, DIN, NZ, 6144, 8, F_WIN, scr, r, F.lane); continue; } r -= I_IN;
        if (r < I_P) { p0_transpose_item(F_w_pa, MW, D, D, 1 << 30, 0, F_WA, scr, r, F.lane); continue; } r -= I_P;
        if (r < I_P) { p0_transpose_item(F_w_pb, MW, D, D, 1 << 30, 0, F_WB, scr, r, F.lane); continue; } r -= I_P;
        if (r < I_O) { p0_transpose_item(F_w_out, D, D, D, 1 << 30, 0, F_WOUT, scr, r, F.lane); continue; } r -= I_O;
        if (r < I_U) { p0_transpose_item(F_w_up, D, FF, FF, 1 << 30, 0, F_WUP, scr, r, F.lane); continue; } r -= I_U;
        p0_transpose_item(F_w_dn, FF, D, D, 1 << 30, 0, F_WDN, scr, r, F.lane);
    }
    __syncthreads();
    LAS float* wfg = (LAS float*)(F.lds + RING_OFF);
    for (int idx = F.tid; idx < 8 * D; idx += NWAVES * 64) { const int k = idx >> 3, h = idx & 7; wfg[h * D + k] = F_w_in[(size_t)k * DIN + 6144 + h] * F_g_mix[k]; }
    __syncthreads();
    f32x4 gv[8];
#pragma unroll
    for (int j = 0; j < 8; ++j) gv[j] = *((const GAS f32x4*)F_g_mix + F.lane + 64 * j);
    for (int m = gw; m < S; m += NGW) {
        const GAS f32x4* xr = (const GAS f32x4*)(F_x + (size_t)m * D) + F.lane;
        f32x4 v[8]; float ss = 0.f;
#pragma unroll
        for (int j = 0; j < 8; ++j) { v[j] = xr[64 * j]; ss += (v[j].x * v[j].x + v[j].y * v[j].y) + (v[j].z * v[j].z + v[j].w * v[j].w); }
        const float rstd = 1.0f / sqrtf(wave_sum(ss) * (1.0f / D) + EPS);
        GAS unsigned long long* o8 = (GAS unsigned long long*)(F_XN + (size_t)m * D) + F.lane;
#pragma unroll
        for (int j = 0; j < 8; ++j) { const f32x4 hn = v[j] * gv[j] * rstd; o8[64 * j] = (unsigned long long)pk2(hn.x, hn.y) | ((unsigned long long)pk2(hn.z, hn.w) << 32); }
        float fl = 0.f;
#pragma unroll 1
        for (int h = 0; h < 8; ++h) { float a = 0.f;
#pragma unroll
            for (int j = 0; j < 8; ++j) { const f32x4 w = *((const LAS f32x4*)(wfg + h * D) + F.lane + 64 * j); a += (v[j].x * w.x + v[j].y * w.y) + (v[j].z * w.z + v[j].w * w.w); }
            a = wave_sum(a) * rstd; if (F.lane == h) fl = a; }
        if (F.lane < 8) F_FLOG[(size_t)m * 8 + F.lane] = fl;
    }
}
struct Top3 { float v0, v1, v2; int i0, i1, i2; };
__device__ __forceinline__ void top3_insert(Top3& T, float v, int n) {
    const bool b0 = v > T.v0 || (v == T.v0 && n < T.i0), b1 = v > T.v1 || (v == T.v1 && n < T.i1), b2 = v > T.v2 || (v == T.v2 && n < T.i2);
    if (b0) { T.v2 = T.v1; T.i2 = T.i1; T.v1 = T.v0; T.i1 = T.i0; T.v0 = v; T.i0 = n; }
    else if (b1) { T.v2 = T.v1; T.i2 = T.i1; T.v1 = v; T.i1 = n; }
    else if (b2) { T.v2 = v; T.i2 = n; }
}
__device__ __forceinline__ void route_item(int h, int b, const bf16* __restrict__ qa, const float* km, unsigned* __restrict__ selmask, LAS float* lds  ) {
    const int tid = threadIdx.x;
    LAS float* kml = lds; LAS float* xv = lds + 4096; LAS int* xi = (LAS int*)(lds + 4096 + 768);
    for (int i = tid; i < 4096; i += 512) kml[i] = __hip_atomic_load(km + (size_t)h * 4096 + i, __ATOMIC_RELAXED, __HIP_MEMORY_SCOPE_AGENT);
    __syncthreads();
    const int q = tid & 255, par = tid >> 8, t = b * 256 + q;
    float g[16];
#pragma unroll
    for (int i = 0; i < 16; ++i) g[i] = 0.f;
    const bf16* qrow = qa + ((size_t)h * S + t) * HD;
    for (int d0 = 0; d0 < 128; d0 += 8) {
        const uint4 raw = *(const uint4*)(qrow + d0);
        float qv[8]; qv[0] = __uint_as_float(raw.x << 16); qv[1] = __uint_as_float(raw.x & 0xffff0000u); qv[2] = __uint_as_float(raw.y << 16); qv[3] = __uint_as_float(raw.y & 0xffff0000u);
        qv[4] = __uint_as_float(raw.z << 16); qv[5] = __uint_as_float(raw.z & 0xffff0000u); qv[6] = __uint_as_float(raw.w << 16); qv[7] = __uint_as_float(raw.w & 0xffff0000u);
#pragma unroll
        for (int i = 0; i < 16; ++i) { const LAS float* kr = kml + (2 * i + par) * 128 + d0;
#pragma unroll
            for (int e = 0; e < 8; ++e) g[i] += qv[e] * kr[e]; }
    }
    Top3 T; T.v0 = T.v1 = T.v2 = -INFINITY; T.i0 = T.i1 = T.i2 = 1 << 20;
#pragma unroll
    for (int i = 0; i < 16; ++i) { const int n = 2 * i + par; if (n < b) top3_insert(T, g[i], n); }
    if (par == 1) { xv[q] = T.v0; xv[256 + q] = T.v1; xv[512 + q] = T.v2; xi[q] = T.i0; xi[256 + q] = T.i1; xi[512 + q] = T.i2; }
    __syncthreads();
    if (par == 0) {
        top3_insert(T, xv[q], xi[q]); top3_insert(T, xv[256 + q], xi[256 + q]); top3_insert(T, xv[512 + q], xi[512 + q]);
        unsigned m = 1u << b;
        if (T.v0 > -INFINITY) m |= 1u << T.i0; if (T.v1 > -INFINITY) m |= 1u << T.i1; if (T.v2 > -INFINITY) m |= 1u << T.i2;
        selmask[(size_t)h * S + t] = m;
    }
    __syncthreads();
}
__device__ __forceinline__ void scan_head(int h, const float* __restrict__ flog, const float* __restrict__ bfg, float* __restrict__ cbn, LAS double* lds  ) {
    const int tid = threadIdx.x; const float bh = bfg[h];
    float lf[16]; double s = 0.0;
#pragma unroll
    for (int i = 0; i < 16; ++i) { const float z = flog[(size_t)(tid * 16 + i) * 8 + h] + bh; lf[i] = fminf(z, 0.f) - log1pf(expf(-fabsf(z))); s += (double)lf[i]; }
    lds[tid] = s; __syncthreads();
    for (int o = 1; o < 512; o <<= 1) { const double v = tid >= o ? lds[tid - o] : 0.0; __syncthreads(); lds[tid] += v; __syncthreads(); }
    double run = tid ? lds[tid - 1] : 0.0;
#pragma unroll
    for (int i = 0; i < 16; ++i) { run += (double)lf[i]; cbn[(size_t)h * S + tid * 16 + i] = (float)(-run * 1.4426950408889634); }
    __syncthreads();
}
__device__ __forceinline__ att::BlockRef p3_ref(const Frame& F, int item, int pass) {
    att::BlockRef r; r.kind = item >> 7; r.h = (item >> 4) & 7; const int s = item & 15, qb = pass ? s : 31 - s; r.P0 = qb * 256;
    r.j_lo = 0; r.j_hi = (r.P0 + 256) / 64;
    if (r.kind == 0) { r.blin = 0.f; r.bref = F_CBN[(size_t)r.h * S + r.P0]; }
    else { const float slope2 = exp2f(-(float)(r.h + 1)) * LOG2E; r.blin = slope2; r.bref = slope2 * (float)r.P0; }
    return r;
}
__global__ void __launch_bounds__(NWAVES * 64, 2) skel_fwd(Args args) {
    extern __shared__ __attribute__((aligned(16))) unsigned char lds[];
    Frame F;
    F.lds = (LAS unsigned char*)lds; F.MISC = (volatile LAS unsigned*)(F.lds + MISC_OFF);
    F.tid = threadIdx.x; F.lane = F.tid & 63; F.wave = __builtin_amdgcn_readfirstlane(F.tid >> 6);
    F.G = gridDim.x; { const int bx = blockIdx.x; F.vcu = (F.G % 8 == 0) ? (bx % 8) * (F.G / 8) + bx / 8 : bx; }
    F.a = &args; F.ctl = (gu32*)(args.ws + WS_CTL);
    for (int u = F.tid; u < (LDS_BYTES - LDSCTL_OFF) / 4; u += NWAVES * 64) ((LAS unsigned*)(F.lds + LDSCTL_OFF))[u] = 0u;
    __syncthreads();
    const int lo = args.ph_lo, hi = args.ph_hi;
    const bool use_bar = (hi - lo) > 1;
    XcdBarrier bar; bar.bar = (unsigned*)(F.ctl + CW_BAR) + args.li * XCD_BAR_WORDS; bar.x = 0; bar.st = nullptr;
    if (use_bar) bar = xcd_barrier_post((unsigned*)(F.ctl + CW_BAR) + args.li * XCD_BAR_WORDS, F.MISC + 8);
#ifdef ONLY_PHASE
#define IN(k) ((k) == ONLY_PHASE && lo <= (k) && (k) < hi)
#else
#define IN(k) (lo <= (k) && (k) < hi)
#endif
#define BOTH(k) (IN(k) && IN((k) + 1))
#define GRID_BAR() xcd_barrier(bar)

    if (IN(0)) { p0_prologue(F); if (BOTH(0)) GRID_BAR(); }
    if (IN(1)) {
        pg8::Gemm g{F_XN, F_XN, F_WIN, F_WIN, D}; pg8::StaticOrder So; So.init(S, NZ, F.G, (int)blockIdx.x);
        pg8::EpiIn E{F_QKV, F_SIG, F_KM};
        pg8::gemm_phase<pg8::EpiIn, pg8::StaticOrder, true, true>(F.lds + RING_OFF, g, So, E);
        if (BOTH(1)) GRID_BAR();
    }
    if (IN(2)) {
        for (int it = blockIdx.x; it < NH * 32; it += F.G) route_item(it >> 5, it & 31, F_QKV, F_KM, F_SEL, (LAS float*)(F.lds + RING_OFF));
        for (int h = blockIdx.x; h < NH; h += F.G) scan_head(h, F_FLOG, F_b_forget, F_CBN, (LAS double*)(F.lds + RING_OFF));
        if (BOTH(2)) GRID_BAR();
    }
    if (IN(3)) {
        att::Seam Sm;
        for (int item = F.vcu; item < 256; item += F.G)
            for (int pass = 0; pass < 2; ++pass) {
                const att::BlockRef cur = p3_ref(F, item, pass);
                att::attn_block(F.a->ws, cur, (att::lptr)(F.lds + RING_OFF), Sm);
            }
        if (BOTH(3)) GRID_BAR();
    }
    if (IN(4)) {
        pg8::Gemm g{F_AM, F_AF, F_WA, F_WB, MW}; pg8::TwoSegOrder So; So.so.init(S, D, F.G, (int)blockIdx.x);
        pg8::EpiProj E{F_SIG, F_MERGED};
        pg8::gemm_phase<pg8::EpiProj, pg8::TwoSegOrder, true, true>(F.lds + RING_OFF, g, So, E);
        if (BOTH(4)) GRID_BAR();
    }
    if (IN(5)) {
        pg8::Gemm g{F_MERGED, F_MERGED, F_WOUT, F_WOUT, D}; pg8::StaticOrder So; So.init(S, D, F.G, (int)blockIdx.x);
        pg8::EpiRes E{F_x, F_g_mlp, F_out, F_X1G, F_SSQ1};
        pg8::gemm_phase<pg8::EpiRes, pg8::StaticOrder, true, true>(F.lds + RING_OFF, g, So, E);
        if (BOTH(5)) GRID_BAR();
    }
    if (IN(6)) {
        pg8::Gemm g{F_X1G, F_X1G, F_WUP, F_WUP, D}; pg8::StaticOrder So; So.init(S, FF, F.G, (int)blockIdx.x);
        pg8::EpiUp E{F_SSQ1, F_HB};
        pg8::gemm_phase<pg8::EpiUp, pg8::StaticOrder, true, true>(F.lds + RING_OFF, g, So, E);
        if (BOTH(6)) GRID_BAR();
    }
    if (IN(7)) {
        pg8::Gemm g{F_HB, F_HB, F_WDN, F_WDN, FF}; pg8::StaticOrder So; So.init(S, D, F.G, (int)blockIdx.x);
        pg8::EpiRes E{F_out, nullptr, F_out, nullptr, F_SSQ2};
        pg8::gemm_phase<pg8::EpiRes, pg8::StaticOrder, true, true>(F.lds + RING_OFF, g, So, E);
        if (BOTH(7)) GRID_BAR();
    }
    if (IN(8)) {
        const int gw = F.vcu * NWAVES + F.wave, NGW = F.G * NWAVES;
        f32x4 gv[8];
#pragma unroll
        for (int j = 0; j < 8; ++j) gv[j] = *((const GAS f32x4*)F_g_fin + F.lane + 64 * j);
        for (int m = gw; m < S; m += NGW) {
            const float rstd = 1.0f / sqrtf((float)((double)F_SSQ2[m] * (1.0 / FIX)) * (1.0f / D) + EPS);
            GAS f32x4* xr = (GAS f32x4*)(F_out + (size_t)m * D) + F.lane;
#pragma unroll
            for (int j = 0; j < 8; ++j) xr[64 * j] = xr[64 * j] * gv[j] * rstd;
        }
    }
#undef IN
#undef BOTH
#undef GRID_BAR
}
__global__ void __launch_bounds__(256) k_transpose(const float* __restrict__ W, int K, int Nsrc, int split, int skip, bf16* __restrict__ WT) {
    __shared__ float tile[32][33];
    const int tx = threadIdx.x & 31, ty = threadIdx.x >> 5, n0 = blockIdx.x * 32, k0 = blockIdx.y * 32;
    const int sc = n0 + tx < split ? n0 + tx : n0 + tx + skip;
#pragma unroll
    for (int j = 0; j < 4; ++j) { const int kk = ty + 8 * j; tile[kk][tx] = W[(size_t)(k0 + kk) * Nsrc + sc]; }
    __syncthreads();
#pragma unroll
    for (int j = 0; j < 4; ++j) { const int n = ty + 8 * j; WT[(size_t)(n0 + n) * K + k0 + tx] = f2bf(tile[tx][n]); }
}
__global__ void __launch_bounds__(256) k_norm_x(const float* __restrict__ x, const float* __restrict__ g, const float* __restrict__ w_in, bf16* __restrict__ XN, float* __restrict__ flog) {
    __shared__ float red[4][9];
    const int t = blockIdx.x, tid = threadIdx.x, lane = tid & 63, wid = tid >> 6;
    float v[8]; float ss = 0.f;
#pragma unroll
    for (int j = 0; j < 8; ++j) { v[j] = x[(size_t)t * D + tid + 256 * j]; ss += v[j] * v[j]; }
    ss = wave_sum(ss); if (lane == 0) red[wid][8] = ss; __syncthreads();
    const float rstd = 1.0f / sqrtf((red[0][8] + red[1][8] + red[2][8] + red[3][8]) * (1.0f / D) + EPS);
    float f[8];
#pragma unroll
    for (int h = 0; h < 8; ++h) f[h] = 0.f;
#pragma unroll
    for (int j = 0; j < 8; ++j) { const int k = tid + 256 * j; const float hn = v[j] * rstd * g[k]; XN[(size_t)t * D + k] = f2bf(hn);
#pragma unroll
        for (int h = 0; h < 8; ++h) f[h] += hn * w_in[(size_t)k * DIN + 6144 + h]; }
#pragma unroll
    for (int h = 0; h < 8; ++h) { f[h] = wave_sum(f[h]); if (lane == 0) red[wid][h] = f[h]; }
    __syncthreads();
    if (tid < 8) flog[t * 8 + tid] = red[0][tid] + red[1][tid] + red[2][tid] + red[3][tid];
}
template <class Epi>
__global__ void __launch_bounds__(256) k_gemm(const bf16* __restrict__ A, int lda, const bf16* __restrict__ Bt, int ldb, int K, Epi e) {
    __shared__ float As[16][65], Bs[16][65];
    const int tid = threadIdx.x, tx = tid & 15, ty = tid >> 4, row0 = blockIdx.y * 64, col0 = blockIdx.x * 64;
    float acc[4][4];
#pragma unroll
    for (int i = 0; i < 4; ++i)
#pragma unroll
        for (int j = 0; j < 4; ++j) acc[i][j] = 0.f;
    for (int k0 = 0; k0 < K; k0 += 16) {
#pragma unroll
        for (int i = 0; i < 4; ++i) { const int idx = tid + 256 * i, r = idx >> 4, kk = idx & 15;
            As[kk][r] = bf2f(A[(size_t)(row0 + r) * lda + k0 + kk]); Bs[kk][r] = bf2f(Bt[(size_t)(col0 + r) * ldb + k0 + kk]); }
        __syncthreads();
#pragma unroll
        for (int kk = 0; kk < 16; ++kk) { float a[4], b[4];
#pragma unroll
            for (int i = 0; i < 4; ++i) { a[i] = As[kk][ty * 4 + i]; b[i] = Bs[kk][tx * 4 + i]; }
#pragma unroll
            for (int i = 0; i < 4; ++i)
#pragma unroll
                for (int j = 0; j < 4; ++j) acc[i][j] += a[i] * b[j]; }
        __syncthreads();
    }
#pragma unroll
    for (int i = 0; i < 4; ++i)
#pragma unroll
        for (int j = 0; j < 4; ++j) e(row0 + ty * 4 + i, col0 + tx * 4 + j, acc[i][j]);
}
struct EpiZ { bf16* qkv; bf16* sig;
    __device__ void operator()(int r, int c, float v) const {
        if (c < 6144) { const int ti = c >> 10, hh = (c & 1023) >> 7, d = c & 127; if (ti == 0 || ti == 3) v *= C2; qkv[((size_t)(ti * 8 + hh) * S + r) * HD + d] = f2bf(v); }
        else { const int gi = (c - 6144) >> 11, cc = (c - 6144) & 2047; sig[((size_t)gi * S + r) * D + cc] = f2bf(1.0f / (1.0f + __builtin_amdgcn_exp2f(-v * LOG2E))); }
    } };
struct EpiPa { const bf16* sig; bf16* merged;
    __device__ void operator()(int r, int c, float v) const { merged[(size_t)r * D + c] = f2bf(bf2f(sig[(size_t)r * D + c]) * v); } };
struct EpiPb { const bf16* sig; bf16* merged;
    __device__ void operator()(int r, int c, float v) const { const size_t i = (size_t)r * D + c; merged[i] = f2bf(bf2f(merged[i]) + bf2f(sig[(size_t)S * D + i]) * v); } };
struct EpiOut { const float* x; const float* g; float* x1; bf16* x1g; unsigned long long* ssq;
    __device__ void operator()(int r, int c, float v) const { const size_t i = (size_t)r * D + c; const float y = x[i] + v; x1[i] = y; x1g[i] = f2bf(y * g[c]);
        atomicAdd(ssq + r, (unsigned long long)((double)(y * y) * FIX)); } };
struct EpiUp { const unsigned long long* ssq; bf16* h;
    __device__ void operator()(int r, int c, float v) const { const float r2 = 1.0f / ((float)((double)ssq[r] * (1.0 / FIX)) * (1.0f / D) + EPS); const float u = fmaxf(v, 0.f); h[(size_t)r * FF + c] = f2bf(u * u * r2); } };
struct EpiDn { float* x2; unsigned long long* ssq;
    __device__ void operator()(int r, int c, float v) const { const size_t i = (size_t)r * D + c; const float y = x2[i] + v; x2[i] = y; atomicAdd(ssq + r, (unsigned long long)((double)(y * y) * FIX)); } };

__global__ void __launch_bounds__(128) k_kmean(const bf16* __restrict__ ka, float* __restrict__ km) {
    const int hn = blockIdx.x, h = hn >> 5, n = hn & 31, d = threadIdx.x; float s = 0.f;
    for (int i = 0; i < 256; ++i) s += bf2f(ka[((size_t)h * S + n * 256 + i) * HD + d]);
    km[(size_t)hn * HD + d] = s;
}
struct Top3_v0 { float v0, v1, v2; int i0, i1, i2; };
__device__ __forceinline__ void top3_insert_v0(Top3_v0& T, float v, int n) {
    const bool b0 = v > T.v0 || (v == T.v0 && n < T.i0), b1 = v > T.v1 || (v == T.v1 && n < T.i1), b2 = v > T.v2 || (v == T.v2 && n < T.i2);
    if (b0) { T.v2 = T.v1; T.i2 = T.i1; T.v1 = T.v0; T.i1 = T.i0; T.v0 = v; T.i0 = n; }
    else if (b1) { T.v2 = T.v1; T.i2 = T.i1; T.v1 = v; T.i1 = n; }
    else if (b2) { T.v2 = v; T.i2 = n; }
}
__device__ __forceinline__ void route_item_v0(int h, int b, const bf16* __restrict__ qa, const float* __restrict__ km, unsigned* __restrict__ selmask, float* lds  ) {
    const int tid = threadIdx.x;
    float* kml = lds; float* xv = lds + 4096; int* xi = (int*)(lds + 4096 + 768);
    for (int i = tid; i < 4096; i += 512) kml[i] = km[(size_t)h * 4096 + i];
    __syncthreads();
    const int q = tid & 255, par = tid >> 8, t = b * 256 + q;
    float g[16];
#pragma unroll
    for (int i = 0; i < 16; ++i) g[i] = 0.f;
    const bf16* qrow = qa + ((size_t)h * S + t) * HD;
    for (int d0 = 0; d0 < 128; d0 += 8) {
        const uint4 raw = *(const uint4*)(qrow + d0);
        float qv[8]; qv[0] = __uint_as_float(raw.x << 16); qv[1] = __uint_as_float(raw.x & 0xffff0000u); qv[2] = __uint_as_float(raw.y << 16); qv[3] = __uint_as_float(raw.y & 0xffff0000u);
        qv[4] = __uint_as_float(raw.z << 16); qv[5] = __uint_as_float(raw.z & 0xffff0000u); qv[6] = __uint_as_float(raw.w << 16); qv[7] = __uint_as_float(raw.w & 0xffff0000u);
#pragma unroll
        for (int i = 0; i < 16; ++i) { const float* kr = kml + (2 * i + par) * 128 + d0;
#pragma unroll
            for (int e = 0; e < 8; ++e) g[i] += qv[e] * kr[e]; }
    }
    Top3_v0 T; T.v0 = T.v1 = T.v2 = -INFINITY; T.i0 = T.i1 = T.i2 = 1 << 20;
#pragma unroll
    for (int i = 0; i < 16; ++i) { const int n = 2 * i + par; if (n < b) top3_insert_v0(T, g[i], n); }
    if (par == 1) { xv[q] = T.v0; xv[256 + q] = T.v1; xv[512 + q] = T.v2; xi[q] = T.i0; xi[256 + q] = T.i1; xi[512 + q] = T.i2; }
    __syncthreads();
    if (par == 0) {
        top3_insert_v0(T, xv[q], xi[q]); top3_insert_v0(T, xv[256 + q], xi[256 + q]); top3_insert_v0(T, xv[512 + q], xi[512 + q]);
        unsigned m = 1u << b;
        if (T.v0 > -INFINITY) m |= 1u << T.i0; if (T.v1 > -INFINITY) m |= 1u << T.i1; if (T.v2 > -INFINITY) m |= 1u << T.i2;
        selmask[(size_t)h * S + t] = m;
    }
    __syncthreads();
}
__global__ void __launch_bounds__(512) k_route(const bf16* __restrict__ qa, const float* __restrict__ km, unsigned* __restrict__ selmask) {
    __shared__ float lds[4096 + 6 * 256];
    route_item_v0(blockIdx.x >> 5, blockIdx.x & 31, qa, km, selmask, lds);
}
__device__ __forceinline__ void scan_head_v0(int h, const float* __restrict__ flog, const float* __restrict__ bfg, float* __restrict__ cbn, double* lds  ) {
    const int tid = threadIdx.x; const float bh = bfg[h];
    float lf[16]; double s = 0.0;
#pragma unroll
    for (int i = 0; i < 16; ++i) { const float z = flog[(size_t)(tid * 16 + i) * 8 + h] + bh; lf[i] = fminf(z, 0.f) - log1pf(expf(-fabsf(z))); s += (double)lf[i]; }
    lds[tid] = s; __syncthreads();
    for (int o = 1; o < 512; o <<= 1) { double v = tid >= o ? lds[tid - o] : 0.0; __syncthreads(); lds[tid] += v; __syncthreads(); }
    double run = tid ? lds[tid - 1] : 0.0;
#pragma unroll
    for (int i = 0; i < 16; ++i) { run += (double)lf[i]; cbn[(size_t)h * S + tid * 16 + i] = (float)(-run * 1.4426950408889634); }
    __syncthreads();
}
__global__ void __launch_bounds__(512) k_scan(const float* __restrict__ flog, const float* __restrict__ bfg, float* __restrict__ cbn) {
    __shared__ double lds[512];
    scan_head_v0(blockIdx.x, flog, bfg, cbn, lds);
}
__global__ void __launch_bounds__(256) k_final(float* __restrict__ out, const unsigned long long* __restrict__ ssq, const float* __restrict__ g) {
    const int t = blockIdx.x; const float rstd = 1.0f / sqrtf((float)((double)ssq[t] * (1.0 / FIX)) * (1.0f / D) + EPS);
    for (int c = threadIdx.x; c < D; c += 256) out[(size_t)t * D + c] = out[(size_t)t * D + c] * rstd * g[c];
}

__global__ void __launch_bounds__(256) k_attn_naive(const bf16* __restrict__ Q, const bf16* __restrict__ K, const bf16* __restrict__ V, const float* __restrict__ cbn,
                                                    const unsigned* __restrict__ selmask, bf16* __restrict__ A, int mode) {
    __shared__ float qs[4][128]; __shared__ float ps[4][64];
    const int tid = threadIdx.x, lane = tid & 63, wid = tid >> 6, qi = blockIdx.x * 4 + wid, h = qi / S, t = qi % S;
    const bf16* qrow = Q + ((size_t)h * S + t) * HD; qs[wid][lane] = bf2f(qrow[lane]); qs[wid][lane + 64] = bf2f(qrow[lane + 64]);
    __syncthreads();
    const float slope2 = exp2f(-(float)(h + 1)) * LOG2E; const unsigned sm = mode ? selmask[(size_t)h * S + t] : 0xffffffffu;
    const float cbt = mode ? 0.f : cbn[(size_t)h * S + t];
    float m = -1e30f, l = 0.f, o0 = 0.f, o1 = 0.f;
    for (int kb = 0; kb <= t; kb += 64) {
        if (mode && !((sm >> (kb >> 8)) & 1u)) continue;
        const int key = kb + lane; const bool valid = key <= t; float s = -INFINITY;
        if (valid) { const bf16* kr = K + ((size_t)h * S + key) * HD; float a = 0.f;
            for (int d = 0; d < 128; d += 8) { const uint4 raw = *(const uint4*)(kr + d); const float* qq = &qs[wid][d];
                a += qq[0] * __uint_as_float(raw.x << 16) + qq[1] * __uint_as_float(raw.x & 0xffff0000u) + qq[2] * __uint_as_float(raw.y << 16) + qq[3] * __uint_as_float(raw.y & 0xffff0000u)
                   + qq[4] * __uint_as_float(raw.z << 16) + qq[5] * __uint_as_float(raw.z & 0xffff0000u) + qq[6] * __uint_as_float(raw.w << 16) + qq[7] * __uint_as_float(raw.w & 0xffff0000u); }
            s = mode ? a - slope2 * (float)(t - key) : a + cbn[(size_t)h * S + key] - cbt; }
        const float cm = wave_max(s), mn = fmaxf(m, cm), alpha = __builtin_amdgcn_exp2f(m - mn), p = valid ? __builtin_amdgcn_exp2f(s - mn) : 0.f;
        l = l * alpha + wave_sum(p); o0 *= alpha; o1 *= alpha; m = mn;
        ps[wid][lane] = p; asm volatile("s_waitcnt lgkmcnt(0)" ::: "memory"); __builtin_amdgcn_wave_barrier();
        const bf16* vb = V + ((size_t)h * S + kb) * HD;
        const int nk = (t - kb + 1) < 64 ? (t - kb + 1) : 64;
        for (int j = 0; j < nk; ++j) { const float pj = ps[wid][j]; o0 += pj * bf2f(vb[(size_t)j * HD + lane]); o1 += pj * bf2f(vb[(size_t)j * HD + lane + 64]); }
        asm volatile("s_waitcnt lgkmcnt(0)" ::: "memory"); __builtin_amdgcn_wave_barrier();
    }
    const float il = 1.0f / l;
    A[(size_t)t * MW + h * HD + lane] = f2bf(o0 * il); A[(size_t)t * MW + h * HD + lane + 64] = f2bf(o1 * il);
}
#ifndef NEWMASK
#define NEWMASK 0x1ff
#endif
extern "C" void kernel_launch(void* const* d_in, const int* in_sizes, int n_in, void* d_out, int out_size, void* d_ws, size_t ws_size, hipStream_t stream) {
    static int grid = 0;
    if (grid == 0) {
        if (n_in != 11 || in_sizes[0] != S * D || out_size != S * D || ws_size < WS_END) { fprintf(stderr, "kernel_launch: unexpected shapes / workspace (n_in %d, ws %zu); nothing launched\n", n_in, ws_size); grid = -1; return; }
        int dev = 0, cus = 0, per_cu = 0;
        if (hipGetDevice(&dev) != hipSuccess || hipDeviceGetAttribute(&cus, hipDeviceAttributeMultiprocessorCount, dev) != hipSuccess) { fprintf(stderr, "kernel_launch: device query failed\n"); grid = -1; return; }
        if (hipFuncSetAttribute((const void*)skel_fwd, hipFuncAttributeMaxDynamicSharedMemorySize, LDS_BYTES) != hipSuccess) { fprintf(stderr, "kernel_launch: hipFuncSetAttribute failed\n"); grid = -1; return; }
        if (hipOccupancyMaxActiveBlocksPerMultiprocessor(&per_cu, (const void*)skel_fwd, NWAVES * 64, LDS_BYTES) != hipSuccess || per_cu < 1) fprintf(stderr, "kernel_launch: note: occupancy query reports %d workgroups per CU\n", per_cu);
        (void)hipGetLastError();
        grid = cus;
    }
    if (grid < 0) return;
    (void)hipMemsetAsync((char*)d_ws + WS_CTL, 0, CTL_ZERO_BYTES, stream);
    Args a{};
    for (int i = 0; i < 11; ++i) a.in[i] = (const float*)d_in[i];
    a.out = (float*)d_out; a.ws = (unsigned char*)d_ws;
    const float* x = (const float*)d_in[0]; const float* g_mix = (const float*)d_in[1]; const float* w_in = (const float*)d_in[2]; const float* b_forget = (const float*)d_in[3];
    const float* w_pa = (const float*)d_in[4]; const float* w_pb = (const float*)d_in[5]; const float* w_out = (const float*)d_in[6]; const float* g_mlp = (const float*)d_in[7];
    const float* w_up = (const float*)d_in[8]; const float* w_dn = (const float*)d_in[9]; const float* g_fin = (const float*)d_in[10];
    unsigned char* ws = (unsigned char*)d_ws; float* out = (float*)d_out;
    bf16* WIN = (bf16*)(ws + WS_WIN); bf16* WA = (bf16*)(ws + WS_WA); bf16* WB = (bf16*)(ws + WS_WB); bf16* WOUT = (bf16*)(ws + WS_WOUT); bf16* WUP = (bf16*)(ws + WS_WUP); bf16* WDN = (bf16*)(ws + WS_WDN);
    bf16* XN = (bf16*)(ws + WS_XN); bf16* MERGED = (bf16*)(ws + WS_MERGED); bf16* QKV = (bf16*)(ws + WS_QKV); bf16* SIG = (bf16*)(ws + WS_SIG);
    bf16* AM = (bf16*)(ws + WS_AM); bf16* AF = (bf16*)(ws + WS_AF); bf16* X1G = (bf16*)(ws + WS_X1G); bf16* HB = (bf16*)(ws + WS_H);
    float* FLOG = (float*)(ws + WS_FLOG); float* CBN = (float*)(ws + WS_CBN); unsigned* SEL = (unsigned*)(ws + WS_SEL);
    unsigned long long* SSQ1 = (unsigned long long*)(ws + CT_SSQ1); unsigned long long* SSQ2 = (unsigned long long*)(ws + CT_SSQ2); float* KM = (float*)(ws + CT_KMEAN);
    auto run = [&](int lo, int hi, int li) { a.ph_lo = lo; a.ph_hi = hi; a.li = li; hipLaunchKernelGGL(skel_fwd, dim3(grid), dim3(NWAVES * 64), LDS_BYTES, stream, a); };
    auto isnew = [](int p) { return ((NEWMASK) >> p) & 1; };
#if MK_N_LAUNCHES == 1
    run(0, 9, 0);
    return;
#endif
    if (isnew(0)) run(0, 1, 0); else {
        k_transpose<<<dim3(NZ / 32, D / 32), 256, 0, stream>>>(w_in, D, DIN, 6144, 8, WIN);
        k_transpose<<<dim3(D / 32, MW / 32), 256, 0, stream>>>(w_pa, MW, D, 1 << 30, 0, WA);
        k_transpose<<<dim3(D / 32, MW / 32), 256, 0, stream>>>(w_pb, MW, D, 1 << 30, 0, WB);
        k_transpose<<<dim3(D / 32, D / 32), 256, 0, stream>>>(w_out, D, D, 1 << 30, 0, WOUT);
        k_transpose<<<dim3(FF / 32, D / 32), 256, 0, stream>>>(w_up, D, FF, 1 << 30, 0, WUP);
        k_transpose<<<dim3(D / 32, FF / 32), 256, 0, stream>>>(w_dn, FF, D, 1 << 30, 0, WDN);
        k_norm_x<<<S, 256, 0, stream>>>(x, g_mix, w_in, XN, FLOG); }
    if (isnew(1)) {
#ifdef EXP_NAIVE_FIRST
        k_gemm<EpiZ><<<dim3(NZ / 64, S / 64), 256, 0, stream>>>(XN, D, WIN, D, D, EpiZ{QKV, SIG});
#endif
        run(1, 2, 0);
#ifdef EXP_KMEAN_NAIVE
        k_kmean<<<256, 128, 0, stream>>>(QKV + 1 * QKV_T, KM);
#endif
    } else {
        k_gemm<EpiZ><<<dim3(NZ / 64, S / 64), 256, 0, stream>>>(XN, D, WIN, D, D, EpiZ{QKV, SIG});
        k_kmean<<<256, 128, 0, stream>>>(QKV + 1 * QKV_T, KM); }
    if (isnew(2)) run(2, 3, 0); else { k_route<<<256, 512, 0, stream>>>(QKV, KM, SEL); k_scan<<<8, 512, 0, stream>>>(FLOG, b_forget, CBN); }
    if (isnew(3)) run(3, 4, 0); else {
    k_attn_naive<<<NH * S / 4, 256, 0, stream>>>(QKV + 0 * QKV_T, QKV + 1 * QKV_T, QKV + 2 * QKV_T, CBN, SEL, AM, 1);
    k_attn_naive<<<NH * S / 4, 256, 0, stream>>>(QKV + 3 * QKV_T, QKV + 4 * QKV_T, QKV + 5 * QKV_T, CBN, SEL, AF, 0); }
    if (isnew(4)) run(4, 5, 0); else {
        k_gemm<EpiPa><<<dim3(D / 64, S / 64), 256, 0, stream>>>(AM, MW, WA, MW, MW, EpiPa{SIG, MERGED});
        k_gemm<EpiPb><<<dim3(D / 64, S / 64), 256, 0, stream>>>(AF, MW, WB, MW, MW, EpiPb{SIG, MERGED}); }
    if (isnew(5)) run(5, 6, 0); else k_gemm<EpiOut><<<dim3(D / 64, S / 64), 256, 0, stream>>>(MERGED, D, WOUT, D, D, EpiOut{x, g_mlp, out, X1G, SSQ1});
    if (isnew(6)) run(6, 7, 0); else k_gemm<EpiUp><<<dim3(FF / 64, S / 64), 256, 0, stream>>>(X1G, D, WUP, D, D, EpiUp{SSQ1, HB});
    if (isnew(7)) run(7, 8, 0); else k_gemm<EpiDn><<<dim3(D / 64, S / 64), 256, 0, stream>>>(HB, FF, WDN, FF, FF, EpiDn{out, SSQ2});
    if (isnew(8)) run(8, 9, 0); else k_final<<<S, 256, 0, stream>>>(out, SSQ2, g_fin);
}
```

```cpp
#include <hip/hip_runtime.h>
#include <cstdio>
#include <cstdint>

typedef unsigned short bf16;
constexpr int S = 8192, D = 2048, NH = 8, HD = 128, MW = 1024, FF = 8192, DIN = 10248, NZ = 10240;
constexpr float EPS = 1e-6f;
constexpr float LOG2E = 1.4426950408889634f;
constexpr float C2 = 0.08838834764831845f * 1.4426950408889634f;
constexpr double FIX = 4294967296.0;

constexpr size_t MiB = 1u << 20;
constexpr size_t WS_CTL = 0, CTL_ZERO_BYTES = 1 * MiB;
constexpr size_t CT_SSQ1 = 64 * 1024, CT_SSQ2 = 128 * 1024, CT_KMEAN = 256 * 1024;
constexpr size_t CT_MISC = 192 * 1024;
constexpr int CW_BAR = 4096;
constexpr size_t WS_FLOG = 1 * MiB, WS_CBN = WS_FLOG + 256 * 1024, WS_SEL = WS_CBN + 256 * 1024;
constexpr size_t WS_WIN = 2 * MiB, WS_WA = 42 * MiB, WS_WB = 46 * MiB, WS_WOUT = 50 * MiB, WS_WUP = 58 * MiB, WS_WDN = 90 * MiB;
constexpr size_t WS_XN = 122 * MiB, WS_MERGED = WS_XN;
constexpr size_t WS_LIST = WS_XN, WS_LSE = WS_XN + 8 * MiB, WS_BLK = WS_XN + 9 * MiB;
constexpr float PRUNE_T = 40.0f;
constexpr size_t WS_QKV = 154 * MiB, WS_SIG = 250 * MiB, WS_END = 314 * MiB;
constexpr size_t WS_AM = 2 * MiB, WS_AF = 18 * MiB, WS_X1G = 2 * MiB, WS_H = 154 * MiB;
constexpr size_t QKV_T = (size_t)NH * S * HD;

__device__ __forceinline__ float bf2f(bf16 v) { return __uint_as_float((unsigned)v << 16); }
__device__ __forceinline__ float wave_sum(float v) {
#pragma unroll
    for (int o = 1; o < 64; o <<= 1) v += __shfl_xor(v, o);
    return v;
}
__device__ __forceinline__ float wave_max(float v) {
#pragma unroll
    for (int o = 1; o < 64; o <<= 1) v = fmaxf(v, __shfl_xor(v, o));
    return v;
}
namespace pg8 {
#define PG8_LAS __attribute__((address_space(3)))
typedef unsigned short bf16_t;
typedef short bf16x8 __attribute__((ext_vector_type(8)));
typedef float f32x4 __attribute__((ext_vector_type(4)));
typedef unsigned u32x4 __attribute__((ext_vector_type(4)));
constexpr int BM = 256, BK = 64, HALF = 128, HTB = HALF * BK * 2  , STAGE_BYTES = 8 * HTB, NXCD = 8, WGM = 8;

__host__ __device__ __forceinline__ int lds_byte(int r, int c) { const int st = (r >> 4) * 2 + (c >> 5), rr = r & 15, cc = c & 31, ob = rr * 64 + cc * 2; return st * 1024 + (ob ^ (((ob >> 9) & 1) << 5)); }
__host__ __device__ __forceinline__ void stage_rc(int b, int& R, int& C) { const int st = b / 1024, sb = b % 1024, swz = sb ^ (((sb >> 9) & 1) << 5); R = (st >> 1) * 16 + swz / 64; C = (st & 1) * 32 + (swz % 64) / 2; }
__host__ __device__ __forceinline__ int perm32(int rho) { const int n = rho >> 4, i = rho & 15; return 8 * (i >> 2) + 4 * n + (i & 3); }

struct Unit { int pm, pn, seg; };
struct Gemm { const bf16_t* A0; const bf16_t* A1; const bf16_t* B0; const bf16_t* B1; int K; };

struct StaticOrder {
    int nM, nN, nwg, G, c;
    __host__ __device__ void init(int M, int N, int G_, int c_) { nM = M / BM; nN = N / BM; nwg = nM * nN; G = G_; c = c_; }
    __host__ __device__ bool next(int i, Unit& u) const {
        const long L = (long)i * G + c; if (L >= nwg) return false;
        int wgid = (int)L; { const int q = nwg / NXCD, r = nwg % NXCD, xcd = wgid % NXCD, off = wgid / NXCD; wgid = (xcd < r ? xcd * (q + 1) : r * (q + 1) + (xcd - r) * q) + off; }
        const int nig = WGM * nN, gid = wgid / nig, fm = gid * WGM, gsz = (nM - fm) < WGM ? (nM - fm) : WGM;
        u.pm = fm + ((wgid % nig) % gsz); u.pn = (wgid % nig) / gsz; u.seg = 0; return true;
    }
    __device__ __forceinline__ void a_ready(const Unit&) const {}
    __device__ __forceinline__ void done(const Unit&) const {}
};

typedef float f32x2_t __attribute__((ext_vector_type(2))); typedef __bf16 bf16x2_t __attribute__((ext_vector_type(2)));
__device__ __forceinline__ unsigned cvt_pk_bf16(float lo, float hi) { f32x2_t v = {lo, hi}; bf16x2_t b = __builtin_convertvector(v, bf16x2_t); return __builtin_bit_cast(unsigned, b); }
typedef unsigned u32x2 __attribute__((ext_vector_type(2)));
__device__ __forceinline__ float sigmoidf_fast(float v) { return __builtin_amdgcn_rcpf(1.0f + __builtin_amdgcn_exp2f(-v * LOG2E)); }
__device__ __forceinline__ void unpack8(const u32x4 w, float (&f)[8]) {
    f[0] = __uint_as_float(w.x << 16); f[1] = __uint_as_float(w.x & 0xffff0000u); f[2] = __uint_as_float(w.y << 16); f[3] = __uint_as_float(w.y & 0xffff0000u);
    f[4] = __uint_as_float(w.z << 16); f[5] = __uint_as_float(w.z & 0xffff0000u); f[6] = __uint_as_float(w.w << 16); f[7] = __uint_as_float(w.w & 0xffff0000u);
}
struct EpiIn {
    static constexpr bool PERM = true, AFTER_DRAIN = false, TWO_SEG = false;
    bf16_t* qkv; bf16_t* sig; float* km;
    __device__ __forceinline__ void operator()(const f32x4 (&acc)[2][2][4][2], const Unit& u, int wr, int wc, int fr, int fq) const {
        const int row0 = u.pm * BM + wr * 64 + fr;
        if (u.pn < 24) {
            const int ti = u.pn >> 2; const float sc = (ti == 0 || ti == 3) ? C2 : 1.0f;
#pragma unroll
            for (int bj = 0; bj < 2; ++bj) { const int head = 2 * (u.pn & 3) + bj; bf16_t* base = qkv + ((size_t)(ti * 8 + head) * S) * HD + wc * 32 + 8 * fq;
#pragma unroll
                for (int ai = 0; ai < 2; ++ai)
#pragma unroll
                    for (int m = 0; m < 4; ++m) { const f32x4 v0 = acc[ai][bj][m][0] * sc, v1 = acc[ai][bj][m][1] * sc;
                        u32x4 w; w.x = cvt_pk_bf16(v0[0], v0[1]); w.y = cvt_pk_bf16(v0[2], v0[3]); w.z = cvt_pk_bf16(v1[0], v1[1]); w.w = cvt_pk_bf16(v1[2], v1[3]);
                        *(u32x4*)(base + (size_t)(row0 + ai * HALF + m * 16) * HD) = w; } }
            if (ti == 1) {
#pragma unroll
                for (int bj = 0; bj < 2; ++bj)
#pragma unroll
                    for (int n = 0; n < 2; ++n) { f32x4 s = acc[0][bj][0][n];
#pragma unroll
                        for (int ai = 0; ai < 2; ++ai)
#pragma unroll
                            for (int m = 0; m < 4; ++m) if (ai + m) s += acc[ai][bj][m][n];
#pragma unroll
                        for (int e = 0; e < 4; ++e) { float v = s[e]; v += __shfl_xor(v, 1); v += __shfl_xor(v, 2); v += __shfl_xor(v, 4); v += __shfl_xor(v, 8);
                            if (fr == 0) atomicAdd(km + ((size_t)(2 * (u.pn & 3) + bj) * 32 + u.pm) * HD + wc * 32 + 8 * fq + 4 * n + e, v); } }
            }
        } else {
            const int gi = (u.pn - 24) >> 3, colt = ((u.pn - 24) & 7) * BM;
            bf16_t* base = sig + (size_t)gi * S * D + colt + wc * 32 + 8 * fq;
#pragma unroll
            for (int ai = 0; ai < 2; ++ai)
#pragma unroll
                for (int m = 0; m < 4; ++m) { bf16_t* rowp = base + (size_t)(row0 + ai * HALF + m * 16) * D;
#pragma unroll
                    for (int bj = 0; bj < 2; ++bj) { const f32x4 v0 = acc[ai][bj][m][0], v1 = acc[ai][bj][m][1];
                        u32x4 w; w.x = cvt_pk_bf16(sigmoidf_fast(v0[0]), sigmoidf_fast(v0[1])); w.y = cvt_pk_bf16(sigmoidf_fast(v0[2]), sigmoidf_fast(v0[3]));
                        w.z = cvt_pk_bf16(sigmoidf_fast(v1[0]), sigmoidf_fast(v1[1])); w.w = cvt_pk_bf16(sigmoidf_fast(v1[2]), sigmoidf_fast(v1[3]));
                        *(u32x4*)(rowp + bj * HALF) = w; } }
        }
    }
};
struct EpiProj {
    static constexpr bool PERM = true, AFTER_DRAIN = false, TWO_SEG = true;
    const bf16_t* sig; bf16_t* merged;
    __device__ __forceinline__ void operator()(f32x4 (&acc)[2][2][4][2], const Unit& u, int wr, int wc, int fr, int fq) const {
        const int row0 = u.pm * BM + wr * 64 + fr, col0 = u.pn * BM + wc * 32 + 8 * fq;
#pragma unroll
        for (int ai = 0; ai < 2; ++ai)
#pragma unroll
            for (int m = 0; m < 4; ++m) { const size_t off = (size_t)(row0 + ai * HALF + m * 16) * D + col0;
#pragma unroll
                for (int bj = 0; bj < 2; ++bj) {
                    float fb[8]; unpack8(*(const u32x4*)(sig + (size_t)S * D + off + bj * HALF), fb);
#pragma unroll
                    for (int e = 0; e < 8; ++e) fb[e] = fmaxf(fb[e], 1e-30f);
                    if (u.seg == 0) { float fa[8]; unpack8(*(const u32x4*)(sig + off + bj * HALF), fa);
#pragma unroll
                        for (int e = 0; e < 4; ++e) { acc[ai][bj][m][0][e] *= fa[e] * __builtin_amdgcn_rcpf(fb[e]); acc[ai][bj][m][1][e] *= fa[4 + e] * __builtin_amdgcn_rcpf(fb[4 + e]); } }
                    else { const f32x4 v0 = acc[ai][bj][m][0], v1 = acc[ai][bj][m][1];
                        u32x4 w; w.x = cvt_pk_bf16(v0[0] * fb[0], v0[1] * fb[1]); w.y = cvt_pk_bf16(v0[2] * fb[2], v0[3] * fb[3]); w.z = cvt_pk_bf16(v1[0] * fb[4], v1[1] * fb[5]); w.w = cvt_pk_bf16(v1[2] * fb[6], v1[3] * fb[7]);
                        *(u32x4*)(merged + off + bj * HALF) = w; } }
                asm volatile("" ::: "memory"); }
    }
};
struct EpiRes {
    static constexpr bool PERM = false, AFTER_DRAIN = false, TWO_SEG = false;
    const float* x; const float* g; float* out; bf16_t* xg; unsigned long long* ssq;
    __device__ __forceinline__ void operator()(const f32x4 (&acc)[2][2][4][2], const Unit& u, int wr, int wc, int fr, int fq) const {
        const int row0 = u.pm * BM + wr * 64 + fr, col0 = u.pn * BM + wc * 32 + 4 * fq;
        f32x4 gv[2][2];
#pragma unroll
        for (int bj = 0; bj < 2; ++bj)
#pragma unroll
            for (int n = 0; n < 2; ++n) gv[bj][n] = g ? *(const f32x4*)(g + col0 + bj * HALF + n * 16) : (f32x4){1.f, 1.f, 1.f, 1.f};
#pragma unroll
        for (int ai = 0; ai < 2; ++ai)
#pragma unroll
            for (int m = 0; m < 4; ++m) { const int row = row0 + ai * HALF + m * 16; const size_t off = (size_t)row * D + col0; float ss = 0.f;
#pragma unroll
                for (int bj = 0; bj < 2; ++bj)
#pragma unroll
                    for (int n = 0; n < 2; ++n) { const size_t o = off + bj * HALF + n * 16; const f32x4 y = *(const f32x4*)(x + o) + acc[ai][bj][m][n]; *(f32x4*)(out + o) = y;
                        ss += (y[0] * y[0] + y[1] * y[1]) + (y[2] * y[2] + y[3] * y[3]);
                        if (g) { const f32x4 z = y * gv[bj][n]; u32x2 w; w.x = cvt_pk_bf16(z[0], z[1]); w.y = cvt_pk_bf16(z[2], z[3]); *(u32x2*)(xg + o) = w; } }
                ss += __shfl_xor(ss, 16); ss += __shfl_xor(ss, 32);
                if (fq == 0) atomicAdd(ssq + row, (unsigned long long)((double)ss * FIX));
                asm volatile("" ::: "memory"); }
    }
};
struct EpiUp {
    static constexpr bool PERM = true, AFTER_DRAIN = false, TWO_SEG = false;
    const unsigned long long* ssq; bf16_t* h;
    __device__ __forceinline__ void operator()(const f32x4 (&acc)[2][2][4][2], const Unit& u, int wr, int wc, int fr, int fq) const {
        const int row0 = u.pm * BM + wr * 64 + fr, col0 = u.pn * BM + wc * 32 + 8 * fq;
#pragma unroll
        for (int ai = 0; ai < 2; ++ai)
#pragma unroll
            for (int m = 0; m < 4; ++m) { const int row = row0 + ai * HALF + m * 16;
                const float r2 = 1.0f / ((float)((double)ssq[row] * (1.0 / FIX)) * (1.0f / D) + EPS);
#pragma unroll
                for (int bj = 0; bj < 2; ++bj) { f32x4 v0 = acc[ai][bj][m][0], v1 = acc[ai][bj][m][1];
#pragma unroll
                    for (int e = 0; e < 4; ++e) { const float a = fmaxf(v0[e], 0.f), b = fmaxf(v1[e], 0.f); v0[e] = a * a * r2; v1[e] = b * b * r2; }
                    u32x4 w; w.x = cvt_pk_bf16(v0[0], v0[1]); w.y = cvt_pk_bf16(v0[2], v0[3]); w.z = cvt_pk_bf16(v1[0], v1[1]); w.w = cvt_pk_bf16(v1[2], v1[3]);
                    *(u32x4*)(h + (size_t)row * FF + col0 + bj * HALF) = w; } }
    }
};
struct TwoSegOrder {
    StaticOrder so;
    __host__ __device__ bool next(int i, Unit& u) const { if (!so.next(i >> 1, u)) return false; u.seg = i & 1; return true; }
    __device__ __forceinline__ void a_ready(const Unit&) const {}
    __device__ __forceinline__ void done(const Unit&) const {}
};

template <class Epi, class Sched, bool ALIGN_EPI = false, bool SP2 = false>
__device__ __forceinline__ void gemm_phase(PG8_LAS unsigned char* lds, const Gemm g, const Sched& S, const Epi& E) {
    const int tid = threadIdx.x, wid = __builtin_amdgcn_readfirstlane(tid >> 6), lane = tid & 63, wr = wid >> 2, wc = wid & 3, fr = lane & 15, fq = lane >> 4;
    const int K = g.K, nt = K / BK;
    unsigned voffA[2], voffB[2];
#pragma unroll
    for (int i = 0; i < 2; ++i) { int R, C; stage_rc(tid * 16 + i * 8192, R, C); const int Rb = Epi::PERM ? ((R & ~31) + perm32(R & 31)) : R;
        voffA[i] = (unsigned)(R * K + C) * 2u; voffB[i] = (unsigned)(Rb * K + C) * 2u; }
    const size_t kstep = (size_t)(BK * 2);
    const size_t hstep = (size_t)HALF * K * 2;
    const size_t tstep = 2 * hstep;
    const unsigned ldsw = (unsigned)wid * 1024u;
    const int aoff = lds_byte(wr * 64 + fr, fq * 8), boff = lds_byte(wc * 32 + fr, fq * 8);
#define PG8_SA(b, h) (((b) * 2 + (h)) * HTB)
#define PG8_SB(b, h) ((4 + (b) * 2 + (h)) * HTB)
#define PG8_STAGE(bufoff, gbase, voff) do { _Pragma("unroll") for (int _i = 0; _i < 2; ++_i) \
        __builtin_amdgcn_global_load_lds((const unsigned*)((const char*)(gbase) + (voff)[_i]), (PG8_LAS unsigned*)(lds + (bufoff) + ldsw + _i * 8192), 16, 0, 0); } while (0)
#define PG8_LDA(dst, b, h) do { _Pragma("unroll") for (int m = 0; m < 4; ++m) _Pragma("unroll") for (int k = 0; k < 2; ++k) dst[m][k] = *(const PG8_LAS bf16x8*)(lds + PG8_SA(b, h) + aoff + m * 2048 + k * 1024); } while (0)
#define PG8_LDB(dst, b, h) do { _Pragma("unroll") for (int n = 0; n < 2; ++n) _Pragma("unroll") for (int k = 0; k < 2; ++k) dst[n][k] = *(const PG8_LAS bf16x8*)(lds + PG8_SB(b, h) + boff + n * 2048 + k * 1024); } while (0)
#define PG8_MMA(ai, bj, At, Bt) do { __builtin_amdgcn_s_setprio(1); _Pragma("unroll") for (int m = 0; m < 4; ++m) _Pragma("unroll") for (int n = 0; n < 2; ++n) _Pragma("unroll") for (int k = 0; k < 2; ++k) \
        acc[ai][bj][m][n] = __builtin_amdgcn_mfma_f32_16x16x32_bf16(Bt[n][k], At[m][k], acc[ai][bj][m][n], 0, 0, 0); __builtin_amdgcn_s_setprio(0); } while (0)
#define PG8_WAIT_V(n) asm volatile("s_waitcnt vmcnt(" #n ")" ::: "memory")
#define PG8_WAIT_L(n) asm volatile("s_waitcnt lgkmcnt(" #n ")" ::: "memory")
#define PG8_BAR __builtin_amdgcn_s_barrier()
#define PG8_SCHED __builtin_amdgcn_sched_barrier(0)
    Unit cur, nxt; int ui = 0;
    if (!S.next(0, cur)) return;
    f32x4 acc[2][2][4][2];
#pragma unroll
    for (int a = 0; a < 2; ++a)
#pragma unroll
        for (int b = 0; b < 2; ++b)
#pragma unroll
            for (int m = 0; m < 4; ++m)
#pragma unroll
                for (int n = 0; n < 2; ++n) acc[a][b][m][n] = (f32x4){0.f, 0.f, 0.f, 0.f};
    bf16x8 At[4][2], B0[2][2], B1[2][2];
    const char* cA = (const char*)(cur.seg ? g.A1 : g.A0) + (size_t)cur.pm * tstep; const char* cB = (const char*)(cur.seg ? g.B1 : g.B0) + (size_t)cur.pn * tstep;
    S.a_ready(cur);
    if constexpr (SP2) {
        PG8_STAGE(PG8_SB(0, 0), cB, voffB); PG8_STAGE(PG8_SB(0, 1), cB + hstep, voffB); PG8_STAGE(PG8_SA(0, 0), cA, voffA); PG8_STAGE(PG8_SA(0, 1), cA + hstep, voffA);
        if (wr == 1) PG8_BAR;
        PG8_WAIT_V(2); PG8_BAR;
        PG8_STAGE(PG8_SB(1, 0), cB + kstep, voffB); PG8_STAGE(PG8_SA(1, 0), cA + kstep, voffA); PG8_STAGE(PG8_SB(1, 1), cB + hstep + kstep, voffB);
        PG8_WAIT_V(6); PG8_BAR;
    } else {
        PG8_STAGE(PG8_SB(0, 0), cB, voffB); PG8_STAGE(PG8_SA(0, 0), cA, voffA); PG8_STAGE(PG8_SB(0, 1), cB + hstep, voffB); PG8_STAGE(PG8_SA(0, 1), cA + hstep, voffA);
        if (wr == 1) PG8_BAR;
        PG8_WAIT_V(4); PG8_BAR;
        PG8_STAGE(PG8_SB(1, 0), cB + kstep, voffB); PG8_STAGE(PG8_SA(1, 0), cA + kstep, voffA); PG8_STAGE(PG8_SB(1, 1), cB + hstep + kstep, voffB);
        PG8_WAIT_V(6); PG8_BAR;
    }
    for (;;) {
        const bool has_next = S.next(ui + 1, nxt);
        const char* nA = has_next ? (const char*)(nxt.seg ? g.A1 : g.A0) + (size_t)nxt.pm * tstep : cA; const char* nB = has_next ? (const char*)(nxt.seg ? g.B1 : g.B0) + (size_t)nxt.pn * tstep : cB;
        for (int t = 0; t < nt; t += 2) {
            const bool last = (t == nt - 2);
            const char* a1 = cA + (size_t)(t + 1) * kstep;
            const char* a2 = last ? nA : cA + (size_t)(t + 2) * kstep; const char* b2 = last ? nB : cB + (size_t)(t + 2) * kstep;
            const char* a3 = a2 + kstep; const char* b3 = b2 + kstep;
            if (last && has_next) S.a_ready(nxt);
            if constexpr (SP2) {
            PG8_LDB(B0, 0, 0); PG8_LDB(B1, 0, 1); PG8_SCHED; PG8_LDA(At, 0, 0); PG8_STAGE(PG8_SA(1, 1), a1 + hstep, voffA);
            PG8_WAIT_V(8); PG8_WAIT_L(0); PG8_BAR; PG8_MMA(0, 0, At, B0); PG8_MMA(0, 1, At, B1); PG8_BAR; PG8_SCHED;
            PG8_LDA(At, 0, 1); PG8_STAGE(PG8_SB(0, 0), b2, voffB); PG8_STAGE(PG8_SB(0, 1), b2 + hstep, voffB); PG8_STAGE(PG8_SA(0, 0), a2, voffA);
            PG8_WAIT_V(8); PG8_WAIT_L(0); PG8_BAR; PG8_MMA(1, 0, At, B0); PG8_MMA(1, 1, At, B1); PG8_BAR; PG8_SCHED;
            PG8_LDB(B0, 1, 0); PG8_LDB(B1, 1, 1); PG8_SCHED; PG8_LDA(At, 1, 0); PG8_STAGE(PG8_SA(0, 1), a2 + hstep, voffA);
            PG8_WAIT_V(8); PG8_WAIT_L(0); PG8_BAR; PG8_MMA(0, 0, At, B0); PG8_MMA(0, 1, At, B1); PG8_BAR; PG8_SCHED;
            PG8_LDA(At, 1, 1); PG8_STAGE(PG8_SB(1, 0), b3, voffB); PG8_STAGE(PG8_SB(1, 1), b3 + hstep, voffB); PG8_STAGE(PG8_SA(1, 0), a3, voffA);
            PG8_WAIT_V(8); PG8_WAIT_L(0); PG8_BAR; PG8_MMA(1, 0, At, B0); PG8_MMA(1, 1, At, B1); PG8_BAR; PG8_SCHED;
            } else {
            PG8_LDB(B0, 0, 0); PG8_SCHED; PG8_LDA(At, 0, 0); PG8_STAGE(PG8_SA(1, 1), a1 + hstep, voffA);
            PG8_WAIT_L(8); PG8_BAR; PG8_WAIT_L(0); PG8_MMA(0, 0, At, B0); PG8_BAR; PG8_SCHED;
            PG8_LDB(B1, 0, 1); PG8_STAGE(PG8_SB(0, 0), b2, voffB);
            PG8_BAR; PG8_WAIT_L(0); PG8_MMA(0, 1, At, B1); PG8_BAR;
            PG8_LDA(At, 0, 1); PG8_STAGE(PG8_SA(0, 0), a2, voffA);
            PG8_BAR; PG8_WAIT_L(0); PG8_MMA(1, 0, At, B0); PG8_BAR; PG8_SCHED;
            PG8_STAGE(PG8_SB(0, 1), b2 + hstep, voffB);
            PG8_WAIT_V(6); PG8_BAR; PG8_MMA(1, 1, At, B1); PG8_BAR;
            PG8_LDB(B0, 1, 0); PG8_SCHED; PG8_LDA(At, 1, 0); PG8_STAGE(PG8_SA(0, 1), a2 + hstep, voffA);
            PG8_WAIT_L(8); PG8_BAR; PG8_WAIT_L(0); PG8_MMA(0, 0, At, B0); PG8_BAR; PG8_SCHED;
            PG8_LDB(B1, 1, 1); PG8_STAGE(PG8_SB(1, 0), b3, voffB);
            PG8_BAR; PG8_WAIT_L(0); PG8_MMA(0, 1, At, B1); PG8_BAR;
            PG8_LDA(At, 1, 1); PG8_STAGE(PG8_SA(1, 0), a3, voffA);
            PG8_BAR; PG8_WAIT_L(0); PG8_MMA(1, 0, At, B0); PG8_BAR; PG8_SCHED;
            PG8_STAGE(PG8_SB(1, 1), b3 + hstep, voffB);
            PG8_WAIT_V(6); PG8_BAR; PG8_MMA(1, 1, At, B1); PG8_BAR;
            }
        }
        if constexpr (ALIGN_EPI) { if (wr == 0) PG8_BAR; }
        if constexpr (!Epi::AFTER_DRAIN) { E(acc, cur, wr, wc, fr, fq); S.done(cur); }
        if (!has_next) break;
        if (!(Epi::TWO_SEG && cur.seg == 0))
#pragma unroll
        for (int a = 0; a < 2; ++a)
#pragma unroll
            for (int b = 0; b < 2; ++b)
#pragma unroll
                for (int m = 0; m < 4; ++m)
#pragma unroll
                    for (int n = 0; n < 2; ++n) acc[a][b][m][n] = (f32x4){0.f, 0.f, 0.f, 0.f};
        cur = nxt; cA = nA; cB = nB; ++ui;
        if constexpr (ALIGN_EPI) { if (wr == 1) PG8_BAR; }
    }
    PG8_WAIT_V(0);
    if constexpr (!ALIGN_EPI) { if (wr == 0) PG8_BAR; }
    PG8_BAR;
    if constexpr (Epi::AFTER_DRAIN) { E.fused(acc, cur, wr, wc, fr, fq, lds, wid, lane); S.done(cur); }
#undef PG8_SA
#undef PG8_SB
#undef PG8_STAGE
#undef PG8_LDA
#undef PG8_LDB
#undef PG8_MMA
#undef PG8_WAIT_V
#undef PG8_WAIT_L
#undef PG8_BAR
#undef PG8_SCHED
}
}

#define GAS __attribute__((address_space(1)))
#define LAS __attribute__((address_space(3)))
typedef unsigned short bf16;
typedef unsigned v4u __attribute__((ext_vector_type(4)));
typedef float f32x4 __attribute__((ext_vector_type(4)));
typedef short bf16x8 __attribute__((ext_vector_type(8)));
typedef GAS unsigned gu32;
typedef GAS unsigned long long gu64;
#define RLX_AGENT __ATOMIC_RELAXED, __HIP_MEMORY_SCOPE_AGENT
#define LDS_WAIT() asm volatile("s_waitcnt lgkmcnt(0)" ::: "memory")
#define VM_WAIT() asm volatile("s_waitcnt vmcnt(0)" ::: "memory")
__device__ __forceinline__ unsigned long long rt() { return __builtin_amdgcn_s_memrealtime(); }
__device__ __forceinline__ unsigned f2bf(float f) { unsigned u = __builtin_bit_cast(unsigned, f); return (u + 0x7fffu + ((u >> 16) & 1u)) >> 16; }
__device__ __forceinline__ unsigned pk2(float lo, float hi) { return f2bf(lo) | (f2bf(hi) << 16); }

#define XB_TMO      128
#define XB_XCNT(j)  (256  + 64 * (j))
#define XB_XSUB(j)  (1280 + 64 * (j))
#define XB_XGEN(j)  (2304 + 64 * (j))
#define XB_TOP      3328
#define XB_TOPGEN   3392
#define XCD_BAR_WORDS 3456
#define XB_SPIN_CAP (1u << 18)

__device__ __forceinline__ unsigned xb_ld(unsigned* p)              { return __hip_atomic_load(p, __ATOMIC_RELAXED, __HIP_MEMORY_SCOPE_AGENT); }
__device__ __forceinline__ unsigned xb_add(unsigned* p, unsigned v) { return __hip_atomic_fetch_add(p, v, __ATOMIC_RELAXED, __HIP_MEMORY_SCOPE_AGENT); }
__device__ __forceinline__ unsigned xb_xcc_id() { return (unsigned)__builtin_amdgcn_s_getreg((3 << 11) | 20) & 0xFu; }
#define XB_SPIN(cond, bar) do { unsigned _sp = 0; while (cond) { __builtin_amdgcn_s_sleep(1); \
    if ((++_sp & 255u) == 0u) { if (xb_ld(&(bar)[XB_TMO])) break; if (_sp > XB_SPIN_CAP) { atomicAdd(&(bar)[XB_TMO], 1u); break; } } } } while (0)

struct XcdBarrier {
    unsigned* bar; unsigned x;
    volatile LAS unsigned* st;
};

__device__ __forceinline__ XcdBarrier xcd_barrier_post(unsigned* bar, volatile LAS unsigned* st) {
    XcdBarrier b; b.bar = bar; b.x = xb_xcc_id(); b.st = st;
    if (threadIdx.x == 0) (void)xb_add(&bar[XB_XCNT(b.x)], 1u);
    return b;
}
__device__ __forceinline__ void xcd_barrier_complete(unsigned* bar, unsigned x, unsigned& nloc, unsigned& nx) {
    const unsigned G = gridDim.x * gridDim.y * gridDim.z;
    unsigned sum, cnt, mine, sp = 0u;
    for (;;) {
        sum = 0u; cnt = 0u; mine = 0u;
#pragma unroll
        for (unsigned j = 0; j < 16; ++j) { const unsigned c = xb_ld(&bar[XB_XCNT(j)]); sum += c; cnt += (c > 0u) ? 1u : 0u; mine = (j == x) ? c : mine; }
        if (sum == G) break;
        __builtin_amdgcn_s_sleep(1);
        if ((++sp & 255u) == 0u) { if (xb_ld(&bar[XB_TMO])) break; if (sp > XB_SPIN_CAP) { atomicAdd(&bar[XB_TMO], 1u); break; } }
    }
    nloc = mine > 0u ? mine : 1u; nx = cnt > 0u ? cnt : 1u;
}

__device__ __forceinline__ void xcd_barrier(const XcdBarrier& b) {
    asm volatile("s_waitcnt vmcnt(0)" ::: "memory");
    __syncthreads();
    if (threadIdx.x == 0) {
        unsigned* bar = b.bar;
        __builtin_amdgcn_s_waitcnt(0);
        unsigned nloc = b.st[0], nx = b.st[1];
        if (nloc == 0u) { xcd_barrier_complete(bar, b.x, nloc, nx); b.st[0] = nloc; b.st[1] = nx; }
        const unsigned old = xb_add(&bar[XB_XSUB(b.x)], 1u);
        const unsigned gen = old / nloc;
        if (old + 1u == (gen + 1u) * nloc) {
            __builtin_amdgcn_fence(__ATOMIC_RELEASE, "agent");
            asm volatile("s_waitcnt vmcnt(0)" ::: "memory");
            const unsigned og = xb_add(&bar[XB_TOP], 1u);
            const unsigned tg = og / nx;
            if (og + 1u == (tg + 1u) * nx) xb_add(&bar[XB_TOPGEN], 1u);
            else XB_SPIN(xb_ld(&bar[XB_TOPGEN]) == tg, bar);
            __builtin_amdgcn_fence(__ATOMIC_ACQUIRE, "agent");
            xb_add(&bar[XB_XGEN(b.x)], 1u);
            asm volatile("s_waitcnt vmcnt(0)" ::: "memory");
        } else {
            XB_SPIN(xb_ld(&bar[XB_XGEN(b.x)]) == gen, bar);
            __builtin_amdgcn_fence(__ATOMIC_ACQUIRE, "agent");
            asm volatile("s_waitcnt vmcnt(0)" ::: "memory");
        }
    }
    __syncthreads();
}

namespace att {
#define ALDS __attribute__((address_space(3)))
typedef ALDS char* lptr; typedef const ALDS char* clptr;
typedef short bf16x8 __attribute__((ext_vector_type(8)));
typedef short s16x4 __attribute__((ext_vector_type(4)));
typedef float f32x16 __attribute__((ext_vector_type(16)));
typedef float f32x4 __attribute__((ext_vector_type(4)));
typedef unsigned u32x4 __attribute__((ext_vector_type(4)));
constexpr int NW = 8, QBLK = 32, KVBLK = 64, QB = 256, DH = 128, LDO = 1024;
constexpr int SHM_V = KVBLK * DH * 2, SHM_K = KVBLK * DH * 2;
constexpr int OFF_WS = 2 * SHM_V + 2 * SHM_K, OFF_BIAS = OFF_WS + NW * 64 * 4, ATT_LDS_BYTES = OFF_BIAS + 2 * 256;
constexpr float THR2 = 11.5f;
#define KSWZ(row, colB) ((row) * 256 + ((colB) ^ (((row) & 7) << 4)))
#define SBAR() __builtin_amdgcn_sched_barrier(0)
__device__ __forceinline__ int v_st(int k, int c) { const int kk = (k & ~0xC) | ((k & 4) << 1) | ((k & 8) >> 1); return ((kk >> 3) * 4 + (c >> 5)) * 512 + ((kk & 7) * 32 + (c & 31)) * 2; }
__device__ __forceinline__ int v_rd_base(int lane) { return ((lane & 3) << 3) | (((lane >> 2) & 3) << 6) | (((lane >> 4) & 1) << 5) | (((lane >> 5) & 1) << 8); }
constexpr int v_rd_off(int d0, int ks, int half) { return d0 * 512 + ks * 4096 + half * 2048; }
__device__ __forceinline__ int crow(int r, int hi) { return (r & 3) + 8 * (r >> 2) + 4 * hi; }
typedef float f32x2_t __attribute__((ext_vector_type(2))); typedef __bf16 bf16x2_t __attribute__((ext_vector_type(2)));
__device__ __forceinline__ unsigned cvtpk(float lo, float hi) { f32x2_t v = {lo, hi}; bf16x2_t b = __builtin_convertvector(v, bf16x2_t); return __builtin_bit_cast(unsigned, b); }
__device__ __forceinline__ bf16x8 ld16(const void* ubase, unsigned voff) { return *reinterpret_cast<const bf16x8*>((const char*)ubase + voff); }
__device__ __forceinline__ void mask_tile(f32x16& p0, f32x16& p1, int dq) {
    const float NEG = -__builtin_inff();
#pragma unroll
    for (int r = 0; r < 16; ++r) { const int c = (r & 3) + 8 * (r >> 2); if (c > dq) p0[r] = NEG; if (c + 32 > dq) p1[r] = NEG; }
}
__device__ __forceinline__ void partialSM(f32x16& p0, f32x16& p1, float& m_reg, float& alpha, bool off) {
    float pmax = p0[0];
#pragma unroll
    for (int r = 1; r < 16; ++r) pmax = fmaxf(pmax, p0[r]);
#pragma unroll
    for (int r = 0; r < 16; ++r) pmax = fmaxf(pmax, p1[r]);
    { auto rr = __builtin_amdgcn_permlane32_swap(__float_as_uint(pmax), __float_as_uint(pmax), false, false);
      pmax = fmaxf(__uint_as_float(rr[0]), __uint_as_float(rr[1])); }
    if (off) pmax = -__builtin_inff();
    float mn;
    if (__builtin_expect(__all((pmax - m_reg) <= THR2), 1)) { mn = m_reg; alpha = 1.f; }
    else { mn = fmaxf(m_reg, pmax); alpha = __builtin_amdgcn_exp2f(m_reg - mn); m_reg = mn; }
    const float mnL = off ? __builtin_inff() : mn;
#pragma unroll
    for (int r = 0; r < 16; ++r) p0[r] = p0[r] - mnL;
#pragma unroll
    for (int r = 0; r < 16; ++r) p1[r] = p1[r] - mnL;
#pragma unroll
    for (int r = 0; r < 16; ++r) p0[r] = __builtin_amdgcn_exp2f(p0[r]);
}
__device__ __forceinline__ void finishSM(f32x16& p0, f32x16& p1, float alpha, float& l_reg, bf16x8& pa0, bf16x8& pa1, bf16x8& pa2, bf16x8& pa3) {
#pragma unroll
    for (int r = 0; r < 16; ++r) p1[r] = __builtin_amdgcn_exp2f(p1[r]);
    float ps = 0;
#pragma unroll
    for (int r = 0; r < 16; ++r) ps += p0[r];
#pragma unroll
    for (int r = 0; r < 16; ++r) ps += p1[r];
    { auto rr = __builtin_amdgcn_permlane32_swap(__float_as_uint(ps), __float_as_uint(ps), false, false);
      ps = __uint_as_float(rr[0]) + __uint_as_float(rr[1]); }
    l_reg = l_reg * alpha + ps;
#define PK4(P, B_, OUT) do { unsigned a0 = cvtpk(P[B_+0], P[B_+1]), a1 = cvtpk(P[B_+2], P[B_+3]);                          \
        unsigned b0 = cvtpk(P[B_+4], P[B_+5]), b1 = cvtpk(P[B_+6], P[B_+7]);                                             \
        auto r0 = __builtin_amdgcn_permlane32_swap(a0, b0, false, false); auto r1 = __builtin_amdgcn_permlane32_swap(a1, b1, false, false); \
        u32x4 w = {r0[0], r1[0], r0[1], r1[1]}; OUT = *reinterpret_cast<bf16x8*>(&w); } while (0)
    PK4(p0, 0, pa0); PK4(p0, 8, pa1); PK4(p1, 0, pa2); PK4(p1, 8, pa3);
#undef PK4
}
template <int KB>
__device__ __forceinline__ void qkt(f32x16& p0, f32x16& p1, clptr K_lds, clptr bias_lds, int r32, int hi, const bf16x8* qr) {
    const ALDS f32x4* bp = (const ALDS f32x4*)(bias_lds + KB * 256 + hi * 16);
    { const f32x4 a = bp[0], b = bp[2], c = bp[4], d = bp[6], e = bp[8], f = bp[10], g = bp[12], h = bp[14];
      p0 = (f32x16){a[0], a[1], a[2], a[3], b[0], b[1], b[2], b[3], c[0], c[1], c[2], c[3], d[0], d[1], d[2], d[3]};
      p1 = (f32x16){e[0], e[1], e[2], e[3], f[0], f[1], f[2], f[3], g[0], g[1], g[2], g[3], h[0], h[1], h[2], h[3]}; }
    clptr kb[4];
#pragma unroll
    for (int dd = 0; dd < 4; ++dd) kb[dd] = K_lds + KB * SHM_K + KSWZ(r32, (dd * 16 + hi * 8) * 2);
#pragma unroll
    for (int d0 = 0; d0 < 8; ++d0) { clptr a = kb[d0 & 3] + (d0 >> 2) * 128;
        bf16x8 b0 = *(const ALDS bf16x8*)(a);
        bf16x8 b1 = *(const ALDS bf16x8*)(a + 32 * 256);
        p0 = __builtin_amdgcn_mfma_f32_32x32x16_bf16(b0, qr[d0], p0, 0, 0, 0);
        p1 = __builtin_amdgcn_mfma_f32_32x32x16_bf16(b1, qr[d0], p1, 0, 0, 0);
        if (d0 == 3) SBAR(); }
}
template <int VB>
__device__ __forceinline__ void pv_tile(f32x16* o, int vb0, bf16x8 pa0, bf16x8 pa1, bf16x8 pa2, bf16x8 pa3) {
#define TRRD(dst, off) asm volatile("ds_read_b64_tr_b16 %0, %1 offset:%2" : "=&v"(dst) : "v"(vb0), "i"(off) : "memory")
#define PV_D0(d0) do { s16x4 l0, l1, l2, l3, h0, h1, h2, h3; constexpr int b_ = VB * SHM_V + v_rd_off(d0, 0, 0); \
        TRRD(l0, b_); TRRD(h0, b_ + 2048); TRRD(l1, b_ + 4096); TRRD(h1, b_ + 6144); TRRD(l2, b_ + 8192); TRRD(h2, b_ + 10240); TRRD(l3, b_ + 12288); TRRD(h3, b_ + 14336); \
        asm volatile("s_waitcnt lgkmcnt(0)" ::: "memory"); SBAR();   \
        o[d0] = __builtin_amdgcn_mfma_f32_32x32x16_bf16(pa0, (bf16x8){l0[0], l0[1], l0[2], l0[3], h0[0], h0[1], h0[2], h0[3]}, o[d0], 0, 0, 0);   \
        o[d0] = __builtin_amdgcn_mfma_f32_32x32x16_bf16(pa1, (bf16x8){l1[0], l1[1], l1[2], l1[3], h1[0], h1[1], h1[2], h1[3]}, o[d0], 0, 0, 0);   \
        o[d0] = __builtin_amdgcn_mfma_f32_32x32x16_bf16(pa2, (bf16x8){l2[0], l2[1], l2[2], l2[3], h2[0], h2[1], h2[2], h2[3]}, o[d0], 0, 0, 0);   \
        o[d0] = __builtin_amdgcn_mfma_f32_32x32x16_bf16(pa3, (bf16x8){l3[0], l3[1], l3[2], l3[3], h3[0], h3[1], h3[2], h3[3]}, o[d0], 0, 0, 0); } while (0)
    PV_D0(0); PV_D0(1); PV_D0(2); PV_D0(3);
#undef PV_D0
#undef TRRD
}
struct BlockRef { int kind, h, P0, j_lo, j_hi; float blin, bref; };
__device__ __forceinline__ const bf16* bq(const unsigned char* ws, const BlockRef& B) { return (const bf16*)(ws + WS_QKV) + (size_t)(B.kind ? 0 : 3) * QKV_T + ((size_t)B.h * S + (B.kind ? 0 : B.P0)) * HD; }
__device__ __forceinline__ const bf16* bk(const unsigned char* ws, const BlockRef& B) { return (const bf16*)(ws + WS_QKV) + (size_t)(B.kind ? 1 : 4) * QKV_T + (size_t)B.h * S * HD; }
__device__ __forceinline__ const bf16* bv(const unsigned char* ws, const BlockRef& B) { return (const bf16*)(ws + WS_QKV) + (size_t)(B.kind ? 2 : 5) * QKV_T + (size_t)B.h * S * HD; }
__device__ __forceinline__ bf16* bo(unsigned char* ws, const BlockRef& B) { return (bf16*)(ws + (B.kind ? WS_AM : WS_AF)) + (size_t)B.P0 * MW + B.h * HD; }
struct Seam { bf16x8 qr[8]; bf16x8 st_v0, st_v1, st_k0, st_k1; float st_b; };
#define VMW() asm volatile("s_waitcnt vmcnt(0)" ::: "memory")
#define VMWN(n) asm volatile("s_waitcnt vmcnt(%0)" :: "i"(n) : "memory")
#define BIASV(B, k0) (tid < 64 ? (((B).kind == 0 ? ((const float*)(ws + WS_CBN))[(size_t)(B).h * S + (k0) + tid] : 0.f) + (B).blin * (float)((k0) + tid) - (B).bref) : 0.f)
#define SLOAD_H(B, k0) do { const char* kb_ = (const char*)bk(ws, B) + (size_t)(k0) * (DH * 2); const char* vb_ = (const char*)bv(ws, B) + (size_t)(k0) * (DH * 2);              \
                            Sm.st_v0 = ld16(vb_, kvoff); Sm.st_v1 = ld16(vb_ + 32 * DH * 2, kvoff); Sm.st_k0 = ld16(kb_, kvoff); Sm.st_k1 = ld16(kb_ + 32 * DH * 2, kvoff); Sm.st_b = BIASV(B, k0); } while (0)
#define SWRITE_HK(bf) do { *(ALDS bf16x8*)(K_lds + (bf) * SHM_K + kws) = Sm.st_k0; *(ALDS bf16x8*)(K_lds + (bf) * SHM_K + kws + 32 * 256) = Sm.st_k1; \
                           if (tid < 64) *(ALDS float*)(B_lds + (bf) * 256 + tid * 4) = Sm.st_b; } while (0)
#define SWRITE_HV(bf) do { *(ALDS bf16x8*)(V_lds + (bf) * SHM_V + vst0) = Sm.st_v0; *(ALDS bf16x8*)(V_lds + (bf) * SHM_V + vst1) = Sm.st_v1; } while (0)
#define SWRITE_H(bf) do { SWRITE_HV(bf); SWRITE_HK(bf); } while (0)
template <int KIND>
__device__ __forceinline__ void attn_block(unsigned char* ws, const BlockRef& cur, lptr lds, Seam& Sm, unsigned ent, bf16* part) {
    const int tid = threadIdx.x, wid = __builtin_amdgcn_readfirstlane(tid >> 6), lane = tid & 63, r32 = lane & 31, hi = lane >> 5;
    const int j_lo = cur.j_lo, NT = cur.j_hi - cur.j_lo;
    const int qlo = (KIND == 0 || cur.P0 >= 0) ? cur.P0 + wid * QBLK : 0x3fffffff, qm = qlo + r32 - 4 * hi;
    lptr V_lds = lds; lptr K_lds = lds + 2 * SHM_V; lptr B_lds = lds + OFF_BIAS;
    ALDS float* wsf = (ALDS float*)(lds + OFF_WS) + wid * 64; ALDS float* li_l = wsf; ALDS float* al_l = wsf + 32;
    const int sr = tid >> 4, sc = (tid & 15) * 8, vst0 = v_st(sr, sc), vst1 = v_st(32 + sr, sc), kws = KSWZ(sr, sc * 2);
    const int vb0 = (int)(unsigned)(size_t)V_lds + v_rd_base(lane);
    const unsigned kvoff = (unsigned)(sr * DH + sc) * 2u, qoff = KIND == 0 ? (unsigned)((wid * QBLK + r32) * DH + hi * 8) * 2u : (unsigned)((ent & 0x1fffu) * DH + hi * 8) * 2u;
#pragma unroll
    for (int d0 = 0; d0 < 8; ++d0) Sm.qr[d0] = ld16((const char*)bq(ws, cur) + d0 * 32, qoff);
    SLOAD_H(cur, j_lo * KVBLK);
    VMW(); SWRITE_H(0);
    __syncthreads();
    float m_reg = -1e30f, l_reg = 0; f32x16 o[4] = {};
#define RESC(a) do { if (__any((a) < 1.f)) { if (hi == 0) al_l[r32] = (a); asm volatile("s_waitcnt lgkmcnt(0)" ::: "memory");              \
                     _Pragma("unroll") for (int d_ = 0; d_ < 4; ++d_) _Pragma("unroll") for (int r = 0; r < 16; ++r) o[d_][r] *= al_l[crow(r, hi)]; } } while (0)
#define KBASE(t) ((j_lo + (t)) * KVBLK)
#define OFFT(t) false
#define MASKT(P0_, P1_, t) do { const int kb_ = KBASE(t); if (kb_ + KVBLK - 1 > qlo) mask_tile(P0_, P1_, qm - kb_); } while (0)
#define TILE(t, BUF) do { f32x16 p0, p1; float al; bf16x8 pa0, pa1, pa2, pa3;                                              \
        if ((t) + 1 < NT) { SLOAD_H(cur, KBASE((t) + 1)); } SBAR();                                                      \
        qkt<BUF>(p0, p1, K_lds, B_lds, r32, hi, Sm.qr);                                                                   \
        MASKT(p0, p1, (t)); partialSM(p0, p1, m_reg, al, OFFT(t)); RESC(al);                                               \
        finishSM(p0, p1, al, l_reg, pa0, pa1, pa2, pa3); SBAR();                                                          \
        pv_tile<BUF>(o, vb0, pa0, pa1, pa2, pa3);                                                                          \
        if ((t) + 1 < NT) { VMW(); SWRITE_H((BUF) ^ 1); }                                                                  \
        __syncthreads(); } while (0)
    int t = 0;
    for (; t + 1 < NT; t += 2) { TILE(t, 0); TILE(t + 1, 1); }
    if (t < NT) TILE(t, 0);
    if (hi == 0) li_l[r32] = l_reg; asm volatile("s_waitcnt lgkmcnt(0)" ::: "memory");
    float rli[16];
#pragma unroll
    for (int r = 0; r < 16; ++r) rli[r] = __builtin_amdgcn_rcpf(li_l[crow(r, hi)]);
    if constexpr (KIND == 0) {
        const unsigned ooff = (unsigned)((wid * QBLK + 4 * hi) * LDO + r32) * 2u;
#pragma unroll
        for (int r = 0; r < 16; ++r) { const int cr = (r & 3) + 8 * (r >> 2);
#pragma unroll
            for (int d0 = 0; d0 < 4; ++d0) { const float v = o[d0][r] * rli[r]; const float vn = __shfl_xor(v, 1);
                if ((r32 & 1) == 0) *(unsigned*)((char*)bo(ws, cur) + (cr * LDO + d0 * 32) * 2 + ooff) = cvtpk(v, vn); } }
    } else {
        const int slot = (ent >> 16) & 3, tq = ent & 0x1fffu;
        if (hi == 0 && !(ent >> 31))
            ((float*)(ws + WS_LSE))[((size_t)slot * NH + cur.h) * S + tq] = m_reg + __builtin_amdgcn_logf(l_reg) - (cur.blin * (float)tq - cur.bref);
#pragma unroll
        for (int r = 0; r < 16; ++r) { const unsigned er = (unsigned)__shfl((int)ent, crow(r, hi)); const bool st = !(er >> 31) && (r32 & 1) == 0;
            char* dst = (char*)part + ((((size_t)((er >> 16) & 3) * NH + cur.h) * S + (er & 0x1fffu)) * HD + r32) * 2;
#pragma unroll
            for (int d0 = 0; d0 < 4; ++d0) { const float v = o[d0][r] * rli[r]; const float vn = __shfl_xor(v, 1);
                if (st) *(unsigned*)(dst + d0 * 64) = cvtpk(v, vn); } }
    }
    asm volatile("s_waitcnt lgkmcnt(0)" ::: "memory");
#undef RESC
#undef KBASE
#undef OFFT
#undef MASKT
#undef TILE
}
#undef VMW
#undef VMWN
#undef BIASV
#undef SLOAD_H
#undef SWRITE_HK
#undef SWRITE_HV
#undef SWRITE_H
#undef KSWZ
#undef SBAR
#undef ALDS
}
constexpr int NWAVES = 8;
constexpr int RING_OFF = 0, RING_BYTES = 131072;
constexpr int LDSCTL_OFF = RING_BYTES, MISC_OFF = LDSCTL_OFF + 320;
constexpr int LDS_BYTES = 147456;
#ifndef MK_N_LAUNCHES
#define MK_N_LAUNCHES 1
#endif
constexpr int N_PHASES = 9;

struct Args { const float* in[11]; float* out; unsigned char* ws; int ph_lo, ph_hi, li, pad; };
struct Frame {
    LAS unsigned char* lds; volatile LAS unsigned* MISC; gu32* ctl;
    int tid, lane, wave, vcu, G;
    const Args* a;
};
#define F_IN(i)   (F.a->in[i])
#define F_x       F_IN(0)
#define F_g_mix   F_IN(1)
#define F_w_in    F_IN(2)
#define F_b_forget F_IN(3)
#define F_w_pa    F_IN(4)
#define F_w_pb    F_IN(5)
#define F_w_out   F_IN(6)
#define F_g_mlp   F_IN(7)
#define F_w_up    F_IN(8)
#define F_w_dn    F_IN(9)
#define F_g_fin   F_IN(10)
#define F_out     (F.a->out)
#define F_WS(off) (F.a->ws + (off))
#define F_WIN  ((bf16*)F_WS(WS_WIN))
#define F_WA   ((bf16*)F_WS(WS_WA))
#define F_WB   ((bf16*)F_WS(WS_WB))
#define F_WOUT ((bf16*)F_WS(WS_WOUT))
#define F_WUP  ((bf16*)F_WS(WS_WUP))
#define F_WDN  ((bf16*)F_WS(WS_WDN))
#define F_XN   ((bf16*)F_WS(WS_XN))
#define F_MERGED ((bf16*)F_WS(WS_MERGED))
#define F_QKV  ((bf16*)F_WS(WS_QKV))
#define F_SIG  ((bf16*)F_WS(WS_SIG))
#define F_AM   ((bf16*)F_WS(WS_AM))
#define F_AF   ((bf16*)F_WS(WS_AF))
#define F_X1G  ((bf16*)F_WS(WS_X1G))
#define F_HB   ((bf16*)F_WS(WS_H))
#define F_FLOG ((float*)F_WS(WS_FLOG))
#define F_CBN  ((float*)F_WS(WS_CBN))
#define F_SEL  ((unsigned*)F_WS(WS_SEL))
#define F_SSQ1 ((unsigned long long*)F_WS(CT_SSQ1))
#define F_SSQ2 ((unsigned long long*)F_WS(CT_SSQ2))
#define F_KM   ((float*)F_WS(CT_KMEAN))
__device__ __forceinline__ void p0_transpose_item(const float* W, int K, int Nsrc, int Ndst, int split, int skip, bf16* WT, LAS float* scr, int item, int lane) {
    const int nblk = Ndst / 32, kb = item / nblk, nb = item % nblk, k0 = 64 * kb, n0 = 32 * nb, s0 = n0 >= split ? n0 + skip : n0;
#pragma unroll 8
    for (int i = 0; i < 32; ++i) { const int kk = 2 * i + (lane >> 5); scr[kk * 33 + (lane & 31)] = W[(size_t)(k0 + kk) * Nsrc + s0 + (lane & 31)]; }
    LDS_WAIT(); asm volatile("" ::: "memory");
    const int c = lane & 7;
#pragma unroll
    for (int j = 0; j < 4; ++j) { const int n = (lane >> 3) + 8 * j; const LAS float* s = scr + (8 * c) * 33 + n;
        v4u o; o.x = pk2(s[0 * 33], s[1 * 33]); o.y = pk2(s[2 * 33], s[3 * 33]); o.z = pk2(s[4 * 33], s[5 * 33]); o.w = pk2(s[6 * 33], s[7 * 33]);
        *(GAS v4u*)(WT + (size_t)(n0 + n) * K + k0 + 8 * c) = o; }
    LDS_WAIT(); asm volatile("" ::: "memory");
}
__device__ __forceinline__ void p0_prologue(Frame& F) {
    LAS float* scr = (LAS float*)(F.lds + RING_OFF + F.wave * 16384);
    const int gw = F.vcu * NWAVES + F.wave, NGW = F.G * NWAVES;
    constexpr int I_IN = (D / 64) * (NZ / 32), I_P = (MW / 64) * (D / 32), I_O = (D / 64) * (D / 32), I_U = (D / 64) * (FF / 32), I_D = (FF / 64) * (D / 32);
    constexpr int NITEMS = I_IN + 2 * I_P + I_O + I_U + I_D;
    for (int it = gw; it < NITEMS; it += NGW) {
        int r = it;
        if (r < I_IN) { p0_transpose_item(F_w_in, D, DIN, NZ, 6144, 8, F_WIN, scr, r, F.lane); continue; } r -= I_IN;
        if (r < I_P) { p0_transpose_item(F_w_pa, MW, D, D, 1 << 30, 0, F_WA, scr, r, F.lane); continue; } r -= I_P;
        if (r < I_P) { p0_transpose_item(F_w_pb, MW, D, D, 1 << 30, 0, F_WB, scr, r, F.lane); continue; } r -= I_P;
        if (r < I_O) { p0_transpose_item(F_w_out, D, D, D, 1 << 30, 0, F_WOUT, scr, r, F.lane); continue; } r -= I_O;
        if (r < I_U) { p0_transpose_item(F_w_up, D, FF, FF, 1 << 30, 0, F_WUP, scr, r, F.lane); continue; } r -= I_U;
        p0_transpose_item(F_w_dn, FF, D, D, 1 << 30, 0, F_WDN, scr, r, F.lane);
    }
    __syncthreads();
    LAS float* wfg = (LAS float*)(F.lds + RING_OFF);
    for (int idx = F.tid; idx < 8 * D; idx += NWAVES * 64) { const int k = idx >> 3, h = idx & 7; wfg[h * D + k] = F_w_in[(size_t)k * DIN + 6144 + h] * F_g_mix[k]; }
    __syncthreads();
    f32x4 gv[8];
#pragma unroll
    for (int j = 0; j < 8; ++j) gv[j] = *((const GAS f32x4*)F_g_mix + F.lane + 64 * j);
    for (int m = gw; m < S; m += NGW) {
        const GAS f32x4* xr = (const GAS f32x4*)(F_x + (size_t)m * D) + F.lane;
        f32x4 v[8]; float ss = 0.f;
#pragma unroll
        for (int j = 0; j < 8; ++j) { v[j] = xr[64 * j]; ss += (v[j].x * v[j].x + v[j].y * v[j].y) + (v[j].z * v[j].z + v[j].w * v[j].w); }
        const float rstd = 1.0f / sqrtf(wave_sum(ss) * (1.0f / D) + EPS);
        GAS unsigned long long* o8 = (GAS unsigned long long*)(F_XN + (size_t)m * D) + F.lane;
#pragma unroll
        for (int j = 0; j < 8; ++j) { const f32x4 hn = v[j] * gv[j] * rstd; o8[64 * j] = (unsigned long long)pk2(hn.x, hn.y) | ((unsigned long long)pk2(hn.z, hn.w) << 32); }
        float fl = 0.f;
#pragma unroll 1
        for (int h = 0; h < 8; ++h) { float a = 0.f;
#pragma unroll
            for (int j = 0; j < 8; ++j) { const f32x4 w = *((const LAS f32x4*)(wfg + h * D) + F.lane + 64 * j); a += (v[j].x * w.x + v[j].y * w.y) + (v[j].z * w.z + v[j].w * w.w); }
            a = wave_sum(a) * rstd; if (F.lane == h) fl = a; }
        if (F.lane < 8) F_FLOG[(size_t)m * 8 + F.lane] = fl;
    }
}
struct Top3 { float v0, v1, v2; int i0, i1, i2; };
__device__ __forceinline__ void top3_insert(Top3& T, float v, int n) {
    const bool b0 = v > T.v0 || (v == T.v0 && n < T.i0), b1 = v > T.v1 || (v == T.v1 && n < T.i1), b2 = v > T.v2 || (v == T.v2 && n < T.i2);
    if (b0) { T.v2 = T.v1; T.i2 = T.i1; T.v1 = T.v0; T.i1 = T.i0; T.v0 = v; T.i0 = n; }
    else if (b1) { T.v2 = T.v1; T.i2 = T.i1; T.v1 = v; T.i1 = n; }
    else if (b2) { T.v2 = v; T.i2 = n; }
}
__device__ __forceinline__ void route_item(int h, int b, const bf16* __restrict__ qa, const float* km, unsigned* cnt, unsigned* __restrict__ list, float* __restrict__ lse, LAS float* lds  ) {
    const int tid = threadIdx.x;
    LAS float* kml = lds; LAS float* xv = lds + 4096; LAS int* xi = (LAS int*)(lds + 4096 + 768); LAS int* hist = (LAS int*)(lds + 4096 + 1536); LAS int* basel = hist + 32;
    for (int i = tid; i < 4096; i += 512) kml[i] = __hip_atomic_load(km + (size_t)h * 4096 + i, __ATOMIC_RELAXED, __HIP_MEMORY_SCOPE_AGENT);
    if (tid < 32) hist[tid] = 0;
    __syncthreads();
    const int q = tid & 255, par = tid >> 8, t = b * 256 + q;
    float g[16];
#pragma unroll
    for (int i = 0; i < 16; ++i) g[i] = 0.f;
    const bf16* qrow = qa + ((size_t)h * S + t) * HD;
    for (int d0 = 0; d0 < 128; d0 += 8) {
        const uint4 raw = *(const uint4*)(qrow + d0);
        float qv[8]; qv[0] = __uint_as_float(raw.x << 16); qv[1] = __uint_as_float(raw.x & 0xffff0000u); qv[2] = __uint_as_float(raw.y << 16); qv[3] = __uint_as_float(raw.y & 0xffff0000u);
        qv[4] = __uint_as_float(raw.z << 16); qv[5] = __uint_as_float(raw.z & 0xffff0000u); qv[6] = __uint_as_float(raw.w << 16); qv[7] = __uint_as_float(raw.w & 0xffff0000u);
#pragma unroll
        for (int i = 0; i < 16; ++i) { const LAS float* kr = kml + (2 * i + par) * 128 + d0;
#pragma unroll
            for (int e = 0; e < 8; ++e) g[i] += qv[e] * kr[e]; }
    }
    Top3 T; T.v0 = T.v1 = T.v2 = -INFINITY; T.i0 = T.i1 = T.i2 = 1 << 20;
#pragma unroll
    for (int i = 0; i < 16; ++i) { const int n = 2 * i + par; if (n < b) top3_insert(T, g[i], n); }
    if (par == 1) { xv[q] = T.v0; xv[256 + q] = T.v1; xv[512 + q] = T.v2; xi[q] = T.i0; xi[256 + q] = T.i1; xi[512 + q] = T.i2; }
    __syncthreads();
    int o0 = 0, o1 = 0, o2 = 0; bool ok0 = false, ok1 = false, ok2 = false;
    if (par == 0) {
        top3_insert(T, xv[q], xi[q]); top3_insert(T, xv[256 + q], xi[256 + q]); top3_insert(T, xv[512 + q], xi[512 + q]);
        ok0 = T.v0 > -INFINITY; ok1 = T.v1 > -INFINITY; ok2 = T.v2 > -INFINITY;
        if (ok0) o0 = __hip_atomic_fetch_add(hist + T.i0, 1, __ATOMIC_RELAXED, __HIP_MEMORY_SCOPE_WORKGROUP);
        if (ok1) o1 = __hip_atomic_fetch_add(hist + T.i1, 1, __ATOMIC_RELAXED, __HIP_MEMORY_SCOPE_WORKGROUP);
        if (ok2) o2 = __hip_atomic_fetch_add(hist + T.i2, 1, __ATOMIC_RELAXED, __HIP_MEMORY_SCOPE_WORKGROUP);
    }
    __syncthreads();
    if (tid < 32) { const int c = hist[tid]; basel[tid] = c ? (int)__hip_atomic_fetch_add(cnt + h * 32 + tid, (unsigned)c, __ATOMIC_RELAXED, __HIP_MEMORY_SCOPE_AGENT) : 0; }
    __syncthreads();
    if (par == 0) {
        if (ok0) list[(size_t)(h * 32 + T.i0) * S + basel[T.i0] + o0] = (unsigned)t | (1u << 16); else lse[((size_t)1 * NH + h) * S + t] = -INFINITY;
        if (ok1) list[(size_t)(h * 32 + T.i1) * S + basel[T.i1] + o1] = (unsigned)t | (2u << 16); else lse[((size_t)2 * NH + h) * S + t] = -INFINITY;
        if (ok2) list[(size_t)(h * 32 + T.i2) * S + basel[T.i2] + o2] = (unsigned)t | (3u << 16); else lse[((size_t)3 * NH + h) * S + t] = -INFINITY;
    }
    __syncthreads();
}
__device__ __forceinline__ void fox_stats(int h, int b, const bf16* __restrict__ qb, const bf16* __restrict__ kb, float* __restrict__ blk, unsigned* kn2, LAS float* lds  ) {
    const int tid = threadIdx.x, row = tid & 255, half = tid >> 8, lane = tid & 63, wid = tid >> 6;
    const bf16* qr = qb + ((size_t)h * S + b * 256 + row) * HD + half * 64; const bf16* kr = kb + ((size_t)h * S + b * 256 + row) * HD + half * 64;
    float q2 = 0.f, dq = 0.f, k2 = 0.f;
#pragma unroll
    for (int d0 = 0; d0 < 64; d0 += 8) { const uint4 a = *(const uint4*)(qr + d0), c = *(const uint4*)(kr + d0);
        const unsigned aw[4] = {a.x, a.y, a.z, a.w}, cw[4] = {c.x, c.y, c.z, c.w};
#pragma unroll
        for (int e = 0; e < 4; ++e) { const float a0 = __uint_as_float(aw[e] << 16), a1 = __uint_as_float(aw[e] & 0xffff0000u), c0 = __uint_as_float(cw[e] << 16), c1 = __uint_as_float(cw[e] & 0xffff0000u);
            q2 += a0 * a0 + a1 * a1; dq += a0 * c0 + a1 * c1; k2 += c0 * c0 + c1 * c1; } }
    if (half == 1) { lds[row] = q2; lds[256 + row] = dq; lds[512 + row] = k2; }
    __syncthreads();
    if (half == 0) { q2 += lds[row]; dq += lds[256 + row]; k2 += lds[512 + row];
        q2 = wave_max(q2); k2 = wave_max(k2); dq = -wave_max(-dq);
        if (lane == 0) { lds[768 + wid] = q2; lds[776 + wid] = dq; lds[784 + wid] = k2; } }
    __syncthreads();
    if (tid == 0) { float a = lds[768], d = lds[776], c = lds[784];
        for (int w = 1; w < 4; ++w) { a = fmaxf(a, lds[768 + w]); d = fminf(d, lds[776 + w]); c = fmaxf(c, lds[784 + w]); }
        blk[h * 32 + b] = a; blk[256 + h * 32 + b] = d; atomicMax(kn2 + h, __float_as_uint(c)); }
    __syncthreads();
}
__device__ __forceinline__ void scan_head(int h, const float* __restrict__ flog, const float* __restrict__ bfg, float* __restrict__ cbn, LAS double* lds  ) {
    const int tid = threadIdx.x; const float bh = bfg[h];
    float lf[16]; double s = 0.0;
#pragma unroll
    for (int i = 0; i < 16; ++i) { const float z = flog[(size_t)(tid * 16 + i) * 8 + h] + bh; lf[i] = fminf(z, 0.f) - log1pf(expf(-fabsf(z))); s += (double)lf[i]; }
    lds[tid] = s; __syncthreads();
    for (int o = 1; o < 512; o <<= 1) { const double v = tid >= o ? lds[tid - o] : 0.0; __syncthreads(); lds[tid] += v; __syncthreads(); }
    double run = tid ? lds[tid - 1] : 0.0;
#pragma unroll
    for (int i = 0; i < 16; ++i) { run += (double)lf[i]; cbn[(size_t)h * S + tid * 16 + i] = (float)(-run * 1.4426950408889634); }
    __syncthreads();
}
__device__ __forceinline__ att::BlockRef p3_fox_ref(const Frame& F, int item) {
    att::BlockRef r; r.kind = 0; r.h = item >> 5; const int qb = item & 31; r.P0 = qb * 256; r.j_hi = (r.P0 + 256) / 64; r.blin = 0.f;
    const float* cb = F_CBN + (size_t)r.h * S; r.bref = cb[r.P0];
    const float* blk = (const float*)F_WS(WS_BLK); const float kn2 = __uint_as_float(((const unsigned*)F_WS(CT_MISC))[256 + r.h]);
    const float bound = sqrtf(blk[r.h * 32 + qb] * kn2) - blk[256 + r.h * 32 + qb] + PRUNE_T;
    const int nb = r.P0 / 64, l0 = F.lane, l1 = F.lane + 64;
    const bool s0 = l0 < nb && (r.bref - cb[l0 < nb ? 64 * l0 + 63 : 0]) >= bound, s1 = l1 < nb && (r.bref - cb[l1 < nb ? 64 * l1 + 63 : 0]) >= bound;
    r.j_lo = __builtin_amdgcn_readfirstlane(__popcll(__ballot(s0)) + __popcll(__ballot(s1)));
    return r;
}
__global__ void __launch_bounds__(NWAVES * 64, 2) skel_fwd(Args args) {
    extern __shared__ __attribute__((aligned(16))) unsigned char lds[];
    Frame F;
    F.lds = (LAS unsigned char*)lds; F.MISC = (volatile LAS unsigned*)(F.lds + MISC_OFF);
    F.tid = threadIdx.x; F.lane = F.tid & 63; F.wave = __builtin_amdgcn_readfirstlane(F.tid >> 6);
    F.G = gridDim.x; { const int bx = blockIdx.x; F.vcu = (F.G % 8 == 0) ? (bx % 8) * (F.G / 8) + bx / 8 : bx; }
    F.a = &args; F.ctl = (gu32*)(args.ws + WS_CTL);
    for (int u = F.tid; u < (LDS_BYTES - LDSCTL_OFF) / 4; u += NWAVES * 64) ((LAS unsigned*)(F.lds + LDSCTL_OFF))[u] = 0u;
    __syncthreads();
    const int lo = args.ph_lo, hi = args.ph_hi;
    const bool use_bar = (hi - lo) > 1;
    XcdBarrier bar; bar.bar = (unsigned*)(F.ctl + CW_BAR) + args.li * XCD_BAR_WORDS; bar.x = 0; bar.st = nullptr;
    if (use_bar) bar = xcd_barrier_post((unsigned*)(F.ctl + CW_BAR) + args.li * XCD_BAR_WORDS, F.MISC + 8);
#ifdef ONLY_PHASE
#define IN(k) ((k) == ONLY_PHASE && lo <= (k) && (k) < hi)
#else
#define IN(k) (lo <= (k) && (k) < hi)
#endif
#define BOTH(k) (IN(k) && IN((k) + 1))
#define GRID_BAR() xcd_barrier(bar)
#ifndef REP_PHASE
#define REP_PHASE -1
#endif
#define REPS(k) for (int rep_ = 0; rep_ < ((k) == REP_PHASE ? 2 : 1); ++rep_)

    if (IN(0)) REPS(0) { p0_prologue(F); if (BOTH(0)) GRID_BAR(); }
    if (IN(1)) REPS(1) {
        pg8::Gemm g{F_XN, F_XN, F_WIN, F_WIN, D}; pg8::StaticOrder So; So.init(S, NZ, F.G, (int)blockIdx.x);
        pg8::EpiIn E{F_QKV, F_SIG, F_KM};
        pg8::gemm_phase<pg8::EpiIn, pg8::StaticOrder, true, true>(F.lds + RING_OFF, g, So, E);
        if (BOTH(1)) GRID_BAR();
    }
    if (IN(2)) REPS(2) {
        for (int it = blockIdx.x; it < NH * 32; it += F.G) { route_item(it >> 5, it & 31, F_QKV, F_KM, (unsigned*)F_WS(CT_MISC), (unsigned*)F_WS(WS_LIST), (float*)F_WS(WS_LSE), (LAS float*)(F.lds + RING_OFF));
            fox_stats(it >> 5, it & 31, F_QKV + 3 * QKV_T, F_QKV + 4 * QKV_T, (float*)F_WS(WS_BLK), (unsigned*)F_WS(CT_MISC) + 256, (LAS float*)(F.lds + RING_OFF)); }
        for (int h = blockIdx.x; h < NH; h += F.G) scan_head(h, F_FLOG, F_b_forget, F_CBN, (LAS double*)(F.lds + RING_OFF));
        if (BOTH(2)) GRID_BAR();
    }
    if (IN(3)) {
        const att::lptr alds = (att::lptr)(F.lds + RING_OFF);
        LAS unsigned* pre = (LAS unsigned*)(F.lds + 98304); LAS unsigned* qslot = pre + 264;
        const unsigned* cnt = (const unsigned*)F_WS(CT_MISC);
        { unsigned v = 0; if (F.tid < 256) v = (__hip_atomic_load(cnt + F.tid, __ATOMIC_RELAXED, __HIP_MEMORY_SCOPE_AGENT) + 255u) >> 8;
          unsigned incl = v;
#pragma unroll
          for (int o = 1; o < 64; o <<= 1) { const unsigned u = __shfl_up(incl, o); if (F.lane >= o) incl += u; }
          if (F.tid < 256 && F.lane == 63) qslot[4 + F.wave] = incl;
          __syncthreads();
          if (F.tid < 256) { unsigned off = 0; for (int w = 0; w < F.wave; ++w) off += qslot[4 + w]; pre[F.tid + 1] = off + incl; if (F.tid == 0) pre[0] = 0; }
          __syncthreads(); }
        const unsigned NCH = pre[256];
        att::Seam Sm;
        for (int it = F.vcu; it < 256; it += F.G) { const att::BlockRef cur = p3_fox_ref(F, it); att::attn_block<0>(F.a->ws, cur, alds, Sm, 0u, nullptr); }
        for (;;) {
            __syncthreads();
            if (F.tid == 0) qslot[0] = __hip_atomic_fetch_add((unsigned*)F_WS(CT_MISC) + 272, 1u, __ATOMIC_RELAXED, __HIP_MEMORY_SCOPE_AGENT);
            __syncthreads();
            const unsigned q = qslot[0];
            if (q >= NCH + 256u) break;
            att::BlockRef cur; cur.kind = 1; unsigned ent; int hn;
            const int row = F.wave * 32 + (F.lane & 31);
            if (q < NCH) { int lo = 0, hi = 256;
                while (hi - lo > 1) { const int mid = (lo + hi) >> 1; if (pre[mid] <= q) lo = mid; else hi = mid; }
                hn = lo; const int c = (int)(q - pre[hn]); const int cv = (int)__hip_atomic_load(cnt + hn, __ATOMIC_RELAXED, __HIP_MEMORY_SCOPE_AGENT);
                const int nrows = (cv - c * 256) < 256 ? (cv - c * 256) : 256, rr = row < nrows ? row : nrows - 1;
                ent = ((const unsigned*)F_WS(WS_LIST))[(size_t)hn * S + c * 256 + rr] | (row >= nrows ? 0x80000000u : 0u); cur.P0 = -1; }
            else { hn = (int)(q - NCH); cur.P0 = (hn & 31) * 256; ent = (unsigned)(cur.P0 + row); }
            cur.h = hn >> 5; const int n = hn & 31; cur.j_lo = 4 * n; cur.j_hi = 4 * n + 4;
            const float slope2 = exp2f(-(float)(cur.h + 1)) * LOG2E; cur.blin = slope2; cur.bref = slope2 * (float)(256 * n);
            att::attn_block<1>(F.a->ws, cur, alds, Sm, ent, (bf16*)F_out);
        }
        GRID_BAR();
        {
            const int gw = F.vcu * NWAVES + F.wave, NGW = F.G * NWAVES; const float* lse = (const float*)F_WS(WS_LSE); const bf16* part = (const bf16*)F_out;
            for (int task = gw; task < S * NH / 4; task += NGW) {
                const int pair = task * 4 + (F.lane >> 4), t = pair >> 3, h = pair & 7, sub = F.lane & 15;
                float ls[4], w[4];
#pragma unroll
                for (int j = 0; j < 4; ++j) ls[j] = lse[((size_t)j * NH + h) * S + t];
                const float M = fmaxf(fmaxf(ls[0], ls[1]), fmaxf(ls[2], ls[3])); float W = 0.f;
#pragma unroll
                for (int j = 0; j < 4; ++j) { w[j] = __builtin_amdgcn_exp2f(ls[j] - M); W += w[j]; }
                const float iw = 1.0f / W; float acc[8];
#pragma unroll
                for (int e = 0; e < 8; ++e) acc[e] = 0.f;
#pragma unroll
                for (int j = 0; j < 4; ++j) if (w[j] > 0.f) { const v4u raw = *(const GAS v4u*)(part + (((size_t)j * NH + h) * S + t) * HD + sub * 8); const float wj = w[j] * iw;
                    acc[0] += wj * __uint_as_float(raw.x << 16); acc[1] += wj * __uint_as_float(raw.x & 0xffff0000u); acc[2] += wj * __uint_as_float(raw.y << 16); acc[3] += wj * __uint_as_float(raw.y & 0xffff0000u);
                    acc[4] += wj * __uint_as_float(raw.z << 16); acc[5] += wj * __uint_as_float(raw.z & 0xffff0000u); acc[6] += wj * __uint_as_float(raw.w << 16); acc[7] += wj * __uint_as_float(raw.w & 0xffff0000u); }
                v4u o; o.x = pk2(acc[0], acc[1]); o.y = pk2(acc[2], acc[3]); o.z = pk2(acc[4], acc[5]); o.w = pk2(acc[6], acc[7]);
                *(GAS v4u*)(F_AM + (size_t)t * MW + h * HD + sub * 8) = o;
            }
        }
        if (BOTH(3)) GRID_BAR();
    }
    if (IN(4)) REPS(4) {
        pg8::Gemm g{F_AM, F_AF, F_WA, F_WB, MW}; pg8::TwoSegOrder So; So.so.init(S, D, F.G, (int)blockIdx.x);
        pg8::EpiProj E{F_SIG, F_MERGED};
        pg8::gemm_phase<pg8::EpiProj, pg8::TwoSegOrder, true, true>(F.lds + RING_OFF, g, So, E);
        if (BOTH(4)) GRID_BAR();
    }
    if (IN(5)) {
        pg8::Gemm g{F_MERGED, F_MERGED, F_WOUT, F_WOUT, D}; pg8::StaticOrder So; So.init(S, D, F.G, (int)blockIdx.x);
        pg8::EpiRes E{F_x, F_g_mlp, F_out, F_X1G, F_SSQ1};
        pg8::gemm_phase<pg8::EpiRes, pg8::StaticOrder, true, true>(F.lds + RING_OFF, g, So, E);
        if (BOTH(5)) GRID_BAR();
    }
    if (IN(6)) REPS(6) {
        pg8::Gemm g{F_X1G, F_X1G, F_WUP, F_WUP, D}; pg8::StaticOrder So; So.init(S, FF, F.G, (int)blockIdx.x);
        pg8::EpiUp E{F_SSQ1, F_HB};
        pg8::gemm_phase<pg8::EpiUp, pg8::StaticOrder, true, true>(F.lds + RING_OFF, g, So, E);
        if (BOTH(6)) GRID_BAR();
    }
    if (IN(7)) {
        pg8::Gemm g{F_HB, F_HB, F_WDN, F_WDN, FF}; pg8::StaticOrder So; So.init(S, D, F.G, (int)blockIdx.x);
        pg8::EpiRes E{F_out, nullptr, F_out, nullptr, F_SSQ2};
        pg8::gemm_phase<pg8::EpiRes, pg8::StaticOrder, true, true>(F.lds + RING_OFF, g, So, E);
        if (BOTH(7)) GRID_BAR();
    }
    if (IN(8)) {
        const int gw = F.vcu * NWAVES + F.wave, NGW = F.G * NWAVES;
        f32x4 gv[8];
#pragma unroll
        for (int j = 0; j < 8; ++j) gv[j] = *((const GAS f32x4*)F_g_fin + F.lane + 64 * j);
        for (int m = gw; m < S; m += NGW) {
            const float rstd = 1.0f / sqrtf((float)((double)F_SSQ2[m] * (1.0 / FIX)) * (1.0f / D) + EPS);
            GAS f32x4* xr = (GAS f32x4*)(F_out + (size_t)m * D) + F.lane;
#pragma unroll
            for (int j = 0; j < 8; ++j) xr[64 * j] = xr[64 * j] * gv[j] * rstd;
        }
    }
#undef IN
#undef BOTH
#undef GRID_BAR
}
__global__ void __launch_bounds__(256) k_transpose(const float* __restrict__ W, int K, int Nsrc, int split, int skip, bf16* __restrict__ WT) {
    __shared__ float tile[32][33];
    const int tx = threadIdx.x & 31, ty = threadIdx.x >> 5, n0 = blockIdx.x * 32, k0 = blockIdx.y * 32;
    const int sc = n0 + tx < split ? n0 + tx : n0 + tx + skip;
#pragma unroll
    for (int j = 0; j < 4; ++j) { const int kk = ty + 8 * j; tile[kk][tx] = W[(size_t)(k0 + kk) * Nsrc + sc]; }
    __syncthreads();
#pragma unroll
    for (int j = 0; j < 4; ++j) { const int n = ty + 8 * j; WT[(size_t)(n0 + n) * K + k0 + tx] = f2bf(tile[tx][n]); }
}
__global__ void __launch_bounds__(256) k_norm_x(const float* __restrict__ x, const float* __restrict__ g, const float* __restrict__ w_in, bf16* __restrict__ XN, float* __restrict__ flog) {
    __shared__ float red[4][9];
    const int t = blockIdx.x, tid = threadIdx.x, lane = tid & 63, wid = tid >> 6;
    float v[8]; float ss = 0.f;
#pragma unroll
    for (int j = 0; j < 8; ++j) { v[j] = x[(size_t)t * D + tid + 256 * j]; ss += v[j] * v[j]; }
    ss = wave_sum(ss); if (lane == 0) red[wid][8] = ss; __syncthreads();
    const float rstd = 1.0f / sqrtf((red[0][8] + red[1][8] + red[2][8] + red[3][8]) * (1.0f / D) + EPS);
    float f[8];
#pragma unroll
    for (int h = 0; h < 8; ++h) f[h] = 0.f;
#pragma unroll
    for (int j = 0; j < 8; ++j) { const int k = tid + 256 * j; const float hn = v[j] * rstd * g[k]; XN[(size_t)t * D + k] = f2bf(hn);
#pragma unroll
        for (int h = 0; h < 8; ++h) f[h] += hn * w_in[(size_t)k * DIN + 6144 + h]; }
#pragma unroll
    for (int h = 0; h < 8; ++h) { f[h] = wave_sum(f[h]); if (lane == 0) red[wid][h] = f[h]; }
    __syncthreads();
    if (tid < 8) flog[t * 8 + tid] = red[0][tid] + red[1][tid] + red[2][tid] + red[3][tid];
}
template <class Epi>
__global__ void __launch_bounds__(256) k_gemm(const bf16* __restrict__ A, int lda, const bf16* __restrict__ Bt, int ldb, int K, Epi e) {
    __shared__ float As[16][65], Bs[16][65];
    const int tid = threadIdx.x, tx = tid & 15, ty = tid >> 4, row0 = blockIdx.y * 64, col0 = blockIdx.x * 64;
    float acc[4][4];
#pragma unroll
    for (int i = 0; i < 4; ++i)
#pragma unroll
        for (int j = 0; j < 4; ++j) acc[i][j] = 0.f;
    for (int k0 = 0; k0 < K; k0 += 16) {
#pragma unroll
        for (int i = 0; i < 4; ++i) { const int idx = tid + 256 * i, r = idx >> 4, kk = idx & 15;
            As[kk][r] = bf2f(A[(size_t)(row0 + r) * lda + k0 + kk]); Bs[kk][r] = bf2f(Bt[(size_t)(col0 + r) * ldb + k0 + kk]); }
        __syncthreads();
#pragma unroll
        for (int kk = 0; kk < 16; ++kk) { float a[4], b[4];
#pragma unroll
            for (int i = 0; i < 4; ++i) { a[i] = As[kk][ty * 4 + i]; b[i] = Bs[kk][tx * 4 + i]; }
#pragma unroll
            for (int i = 0; i < 4; ++i)
#pragma unroll
                for (int j = 0; j < 4; ++j) acc[i][j] += a[i] * b[j]; }
        __syncthreads();
    }
#pragma unroll
    for (int i = 0; i < 4; ++i)
#pragma unroll
        for (int j = 0; j < 4; ++j) e(row0 + ty * 4 + i, col0 + tx * 4 + j, acc[i][j]);
}
struct EpiZ { bf16* qkv; bf16* sig;
    __device__ void operator()(int r, int c, float v) const {
        if (c < 6144) { const int ti = c >> 10, hh = (c & 1023) >> 7, d = c & 127; if (ti == 0 || ti == 3) v *= C2; qkv[((size_t)(ti * 8 + hh) * S + r) * HD + d] = f2bf(v); }
        else { const int gi = (c - 6144) >> 11, cc = (c - 6144) & 2047; sig[((size_t)gi * S + r) * D + cc] = f2bf(1.0f / (1.0f + __builtin_amdgcn_exp2f(-v * LOG2E))); }
    } };
struct EpiPa { const bf16* sig; bf16* merged;
    __device__ void operator()(int r, int c, float v) const { merged[(size_t)r * D + c] = f2bf(bf2f(sig[(size_t)r * D + c]) * v); } };
struct EpiPb { const bf16* sig; bf16* merged;
    __device__ void operator()(int r, int c, float v) const { const size_t i = (size_t)r * D + c; merged[i] = f2bf(bf2f(merged[i]) + bf2f(sig[(size_t)S * D + i]) * v); } };
struct EpiOut { const float* x; const float* g; float* x1; bf16* x1g; unsigned long long* ssq;
    __device__ void operator()(int r, int c, float v) const { const size_t i = (size_t)r * D + c; const float y = x[i] + v; x1[i] = y; x1g[i] = f2bf(y * g[c]);
        atomicAdd(ssq + r, (unsigned long long)((double)(y * y) * FIX)); } };
struct EpiUp { const unsigned long long* ssq; bf16* h;
    __device__ void operator()(int r, int c, float v) const { const float r2 = 1.0f / ((float)((double)ssq[r] * (1.0 / FIX)) * (1.0f / D) + EPS); const float u = fmaxf(v, 0.f); h[(size_t)r * FF + c] = f2bf(u * u * r2); } };
struct EpiDn { float* x2; unsigned long long* ssq;
    __device__ void operator()(int r, int c, float v) const { const size_t i = (size_t)r * D + c; const float y = x2[i] + v; x2[i] = y; atomicAdd(ssq + r, (unsigned long long)((double)(y * y) * FIX)); } };

__global__ void __launch_bounds__(128) k_kmean(const bf16* __restrict__ ka, float* __restrict__ km) {
    const int hn = blockIdx.x, h = hn >> 5, n = hn & 31, d = threadIdx.x; float s = 0.f;
    for (int i = 0; i < 256; ++i) s += bf2f(ka[((size_t)h * S + n * 256 + i) * HD + d]);
    km[(size_t)hn * HD + d] = s;
}
struct Top3_v0 { float v0, v1, v2; int i0, i1, i2; };
__device__ __forceinline__ void top3_insert_v0(Top3_v0& T, float v, int n) {
    const bool b0 = v > T.v0 || (v == T.v0 && n < T.i0), b1 = v > T.v1 || (v == T.v1 && n < T.i1), b2 = v > T.v2 || (v == T.v2 && n < T.i2);
    if (b0) { T.v2 = T.v1; T.i2 = T.i1; T.v1 = T.v0; T.i1 = T.i0; T.v0 = v; T.i0 = n; }
    else if (b1) { T.v2 = T.v1; T.i2 = T.i1; T.v1 = v; T.i1 = n; }
    else if (b2) { T.v2 = v; T.i2 = n; }
}
__device__ __forceinline__ void route_item_v0(int h, int b, const bf16* __restrict__ qa, const float* __restrict__ km, unsigned* __restrict__ selmask, float* lds  ) {
    const int tid = threadIdx.x;
    float* kml = lds; float* xv = lds + 4096; int* xi = (int*)(lds + 4096 + 768);
    for (int i = tid; i < 4096; i += 512) kml[i] = km[(size_t)h * 4096 + i];
    __syncthreads();
    const int q = tid & 255, par = tid >> 8, t = b * 256 + q;
    float g[16];
#pragma unroll
    for (int i = 0; i < 16; ++i) g[i] = 0.f;
    const bf16* qrow = qa + ((size_t)h * S + t) * HD;
    for (int d0 = 0; d0 < 128; d0 += 8) {
        const uint4 raw = *(const uint4*)(qrow + d0);
        float qv[8]; qv[0] = __uint_as_float(raw.x << 16); qv[1] = __uint_as_float(raw.x & 0xffff0000u); qv[2] = __uint_as_float(raw.y << 16); qv[3] = __uint_as_float(raw.y & 0xffff0000u);
        qv[4] = __uint_as_float(raw.z << 16); qv[5] = __uint_as_float(raw.z & 0xffff0000u); qv[6] = __uint_as_float(raw.w << 16); qv[7] = __uint_as_float(raw.w & 0xffff0000u);
#pragma unroll
        for (int i = 0; i < 16; ++i) { const float* kr = kml + (2 * i + par) * 128 + d0;
#pragma unroll
            for (int e = 0; e < 8; ++e) g[i] += qv[e] * kr[e]; }
    }
    Top3_v0 T; T.v0 = T.v1 = T.v2 = -INFINITY; T.i0 = T.i1 = T.i2 = 1 << 20;
#pragma unroll
    for (int i = 0; i < 16; ++i) { const int n = 2 * i + par; if (n < b) top3_insert_v0(T, g[i], n); }
    if (par == 1) { xv[q] = T.v0; xv[256 + q] = T.v1; xv[512 + q] = T.v2; xi[q] = T.i0; xi[256 + q] = T.i1; xi[512 + q] = T.i2; }
    __syncthreads();
    if (par == 0) {
        top3_insert_v0(T, xv[q], xi[q]); top3_insert_v0(T, xv[256 + q], xi[256 + q]); top3_insert_v0(T, xv[512 + q], xi[512 + q]);
        unsigned m = 1u << b;
        if (T.v0 > -INFINITY) m |= 1u << T.i0; if (T.v1 > -INFINITY) m |= 1u << T.i1; if (T.v2 > -INFINITY) m |= 1u << T.i2;
        selmask[(size_t)h * S + t] = m;
    }
    __syncthreads();
}
__global__ void __launch_bounds__(512) k_route(const bf16* __restrict__ qa, const float* __restrict__ km, unsigned* __restrict__ selmask) {
    __shared__ float lds[4096 + 6 * 256];
    route_item_v0(blockIdx.x >> 5, blockIdx.x & 31, qa, km, selmask, lds);
}
__device__ __forceinline__ void scan_head_v0(int h, const float* __restrict__ flog, const float* __restrict__ bfg, float* __restrict__ cbn, double* lds  ) {
    const int tid = threadIdx.x; const float bh = bfg[h];
    float lf[16]; double s = 0.0;
#pragma unroll
    for (int i = 0; i < 16; ++i) { const float z = flog[(size_t)(tid * 16 + i) * 8 + h] + bh; lf[i] = fminf(z, 0.f) - log1pf(expf(-fabsf(z))); s += (double)lf[i]; }
    lds[tid] = s; __syncthreads();
    for (int o = 1; o < 512; o <<= 1) { double v = tid >= o ? lds[tid - o] : 0.0; __syncthreads(); lds[tid] += v; __syncthreads(); }
    double run = tid ? lds[tid - 1] : 0.0;
#pragma unroll
    for (int i = 0; i < 16; ++i) { run += (double)lf[i]; cbn[(size_t)h * S + tid * 16 + i] = (float)(-run * 1.4426950408889634); }
    __syncthreads();
}
__global__ void __launch_bounds__(512) k_scan(const float* __restrict__ flog, const float* __restrict__ bfg, float* __restrict__ cbn) {
    __shared__ double lds[512];
    scan_head_v0(blockIdx.x, flog, bfg, cbn, lds);
}
__global__ void __launch_bounds__(256) k_final(float* __restrict__ out, const unsigned long long* __restrict__ ssq, const float* __restrict__ g) {
    const int t = blockIdx.x; const float rstd = 1.0f / sqrtf((float)((double)ssq[t] * (1.0 / FIX)) * (1.0f / D) + EPS);
    for (int c = threadIdx.x; c < D; c += 256) out[(size_t)t * D + c] = out[(size_t)t * D + c] * rstd * g[c];
}

__global__ void __launch_bounds__(256) k_attn_naive(const bf16* __restrict__ Q, const bf16* __restrict__ K, const bf16* __restrict__ V, const float* __restrict__ cbn,
                                                    const unsigned* __restrict__ selmask, bf16* __restrict__ A, int mode) {
    __shared__ float qs[4][128]; __shared__ float ps[4][64];
    const int tid = threadIdx.x, lane = tid & 63, wid = tid >> 6, qi = blockIdx.x * 4 + wid, h = qi / S, t = qi % S;
    const bf16* qrow = Q + ((size_t)h * S + t) * HD; qs[wid][lane] = bf2f(qrow[lane]); qs[wid][lane + 64] = bf2f(qrow[lane + 64]);
    __syncthreads();
    const float slope2 = exp2f(-(float)(h + 1)) * LOG2E; const unsigned sm = mode ? selmask[(size_t)h * S + t] : 0xffffffffu;
    const float cbt = mode ? 0.f : cbn[(size_t)h * S + t];
    float m = -1e30f, l = 0.f, o0 = 0.f, o1 = 0.f;
    for (int kb = 0; kb <= t; kb += 64) {
        if (mode && !((sm >> (kb >> 8)) & 1u)) continue;
        const int key = kb + lane; const bool valid = key <= t; float s = -INFINITY;
        if (valid) { const bf16* kr = K + ((size_t)h * S + key) * HD; float a = 0.f;
            for (int d = 0; d < 128; d += 8) { const uint4 raw = *(const uint4*)(kr + d); const float* qq = &qs[wid][d];
                a += qq[0] * __uint_as_float(raw.x << 16) + qq[1] * __uint_as_float(raw.x & 0xffff0000u) + qq[2] * __uint_as_float(raw.y << 16) + qq[3] * __uint_as_float(raw.y & 0xffff0000u)
                   + qq[4] * __uint_as_float(raw.z << 16) + qq[5] * __uint_as_float(raw.z & 0xffff0000u) + qq[6] * __uint_as_float(raw.w << 16) + qq[7] * __uint_as_float(raw.w & 0xffff0000u); }
            s = mode ? a - slope2 * (float)(t - key) : a + cbn[(size_t)h * S + key] - cbt; }
        const float cm = wave_max(s), mn = fmaxf(m, cm), alpha = __builtin_amdgcn_exp2f(m - mn), p = valid ? __builtin_amdgcn_exp2f(s - mn) : 0.f;
        l = l * alpha + wave_sum(p); o0 *= alpha; o1 *= alpha; m = mn;
        ps[wid][lane] = p; asm volatile("s_waitcnt lgkmcnt(0)" ::: "memory"); __builtin_amdgcn_wave_barrier();
        const bf16* vb = V + ((size_t)h * S + kb) * HD;
        const int nk = (t - kb + 1) < 64 ? (t - kb + 1) : 64;
        for (int j = 0; j < nk; ++j) { const float pj = ps[wid][j]; o0 += pj * bf2f(vb[(size_t)j * HD + lane]); o1 += pj * bf2f(vb[(size_t)j * HD + lane + 64]); }
        asm volatile("s_waitcnt lgkmcnt(0)" ::: "memory"); __builtin_amdgcn_wave_barrier();
    }
    const float il = 1.0f / l;
    A[(size_t)t * MW + h * HD + lane] = f2bf(o0 * il); A[(size_t)t * MW + h * HD + lane + 64] = f2bf(o1 * il);
}
#ifndef NEWMASK
#define NEWMASK 0x1ff
#endif
extern "C" void kernel_launch(void* const* d_in, const int* in_sizes, int n_in, void* d_out, int out_size, void* d_ws, size_t ws_size, hipStream_t stream) {
    static int grid = 0;
    if (grid == 0) {
        if (n_in != 11 || in_sizes[0] != S * D || out_size != S * D || ws_size < WS_END) { fprintf(stderr, "kernel_launch: unexpected shapes / workspace (n_in %d, ws %zu); nothing launched\n", n_in, ws_size); grid = -1; return; }
        int dev = 0, cus = 0, per_cu = 0;
        if (hipGetDevice(&dev) != hipSuccess || hipDeviceGetAttribute(&cus, hipDeviceAttributeMultiprocessorCount, dev) != hipSuccess) { fprintf(stderr, "kernel_launch: device query failed\n"); grid = -1; return; }
        if (hipFuncSetAttribute((const void*)skel_fwd, hipFuncAttributeMaxDynamicSharedMemorySize, LDS_BYTES) != hipSuccess) { fprintf(stderr, "kernel_launch: hipFuncSetAttribute failed\n"); grid = -1; return; }
        if (hipOccupancyMaxActiveBlocksPerMultiprocessor(&per_cu, (const void*)skel_fwd, NWAVES * 64, LDS_BYTES) != hipSuccess || per_cu < 1) fprintf(stderr, "kernel_launch: note: occupancy query reports %d workgroups per CU\n", per_cu);
        (void)hipGetLastError();
        grid = cus;
    }
    if (grid < 0) return;
    (void)hipMemsetAsync((char*)d_ws + WS_CTL, 0, CTL_ZERO_BYTES, stream);
    Args a{};
    for (int i = 0; i < 11; ++i) a.in[i] = (const float*)d_in[i];
    a.out = (float*)d_out; a.ws = (unsigned char*)d_ws;
    const float* x = (const float*)d_in[0]; const float* g_mix = (const float*)d_in[1]; const float* w_in = (const float*)d_in[2]; const float* b_forget = (const float*)d_in[3];
    const float* w_pa = (const float*)d_in[4]; const float* w_pb = (const float*)d_in[5]; const float* w_out = (const float*)d_in[6]; const float* g_mlp = (const float*)d_in[7];
    const float* w_up = (const float*)d_in[8]; const float* w_dn = (const float*)d_in[9]; const float* g_fin = (const float*)d_in[10];
    unsigned char* ws = (unsigned char*)d_ws; float* out = (float*)d_out;
    bf16* WIN = (bf16*)(ws + WS_WIN); bf16* WA = (bf16*)(ws + WS_WA); bf16* WB = (bf16*)(ws + WS_WB); bf16* WOUT = (bf16*)(ws + WS_WOUT); bf16* WUP = (bf16*)(ws + WS_WUP); bf16* WDN = (bf16*)(ws + WS_WDN);
    bf16* XN = (bf16*)(ws + WS_XN); bf16* MERGED = (bf16*)(ws + WS_MERGED); bf16* QKV = (bf16*)(ws + WS_QKV); bf16* SIG = (bf16*)(ws + WS_SIG);
    bf16* AM = (bf16*)(ws + WS_AM); bf16* AF = (bf16*)(ws + WS_AF); bf16* X1G = (bf16*)(ws + WS_X1G); bf16* HB = (bf16*)(ws + WS_H);
    float* FLOG = (float*)(ws + WS_FLOG); float* CBN = (float*)(ws + WS_CBN); unsigned* SEL = (unsigned*)(ws + WS_SEL);
    unsigned long long* SSQ1 = (unsigned long long*)(ws + CT_SSQ1); unsigned long long* SSQ2 = (unsigned long long*)(ws + CT_SSQ2); float* KM = (float*)(ws + CT_KMEAN);
    auto run = [&](int lo, int hi, int li) { a.ph_lo = lo; a.ph_hi = hi; a.li = li; hipLaunchKernelGGL(skel_fwd, dim3(grid), dim3(NWAVES * 64), LDS_BYTES, stream, a); };
    auto isnew = [](int p) { return ((NEWMASK) >> p) & 1; };
#if MK_N_LAUNCHES == 1
    run(0, 9, 0);
    return;
#endif
    if (isnew(0)) run(0, 1, 0); else {
        k_transpose<<<dim3(NZ / 32, D / 32), 256, 0, stream>>>(w_in, D, DIN, 6144, 8, WIN);
        k_transpose<<<dim3(D / 32, MW / 32), 256, 0, stream>>>(w_pa, MW, D, 1 << 30, 0, WA);
        k_transpose<<<dim3(D / 32, MW / 32), 256, 0, stream>>>(w_pb, MW, D, 1 << 30, 0, WB);
        k_transpose<<<dim3(D / 32, D / 32), 256, 0, stream>>>(w_out, D, D, 1 << 30, 0, WOUT);
        k_transpose<<<dim3(FF / 32, D / 32), 256, 0, stream>>>(w_up, D, FF, 1 << 30, 0, WUP);
        k_transpose<<<dim3(D / 32, FF / 32), 256, 0, stream>>>(w_dn, FF, D, 1 << 30, 0, WDN);
        k_norm_x<<<S, 256, 0, stream>>>(x, g_mix, w_in, XN, FLOG); }
    if (isnew(1)) {
#ifdef EXP_NAIVE_FIRST
        k_gemm<EpiZ><<<dim3(NZ / 64, S / 64), 256, 0, stream>>>(XN, D, WIN, D, D, EpiZ{QKV, SIG});
#endif
        run(1, 2, 0);
#ifdef EXP_KMEAN_NAIVE
        k_kmean<<<256, 128, 0, stream>>>(QKV + 1 * QKV_T, KM);
#endif
    } else {
        k_gemm<EpiZ><<<dim3(NZ / 64, S / 64), 256, 0, stream>>>(XN, D, WIN, D, D, EpiZ{QKV, SIG});
        k_kmean<<<256, 128, 0, stream>>>(QKV + 1 * QKV_T, KM); }
    if (isnew(2)) run(2, 3, 0); else { k_route<<<256, 512, 0, stream>>>(QKV, KM, SEL); k_scan<<<8, 512, 0, stream>>>(FLOG, b_forget, CBN); }
    if (isnew(3)) run(3, 4, 0); else {
    k_attn_naive<<<NH * S / 4, 256, 0, stream>>>(QKV + 0 * QKV_T, QKV + 1 * QKV_T, QKV + 2 * QKV_T, CBN, SEL, AM, 1);
    k_attn_naive<<<NH * S / 4, 256, 0, stream>>>(QKV + 3 * QKV_T, QKV + 4 * QKV_T, QKV + 5 * QKV_T, CBN, SEL, AF, 0); }
    if (isnew(4)) run(4, 5, 0); else {
        k_gemm<EpiPa><<<dim3(D / 64, S / 64), 256, 0, stream>>>(AM, MW, WA, MW, MW, EpiPa{SIG, MERGED});
        k_gemm<EpiPb><<<dim3(D / 64, S / 64), 256, 0, stream>>>(AF, MW, WB, MW, MW, EpiPb{SIG, MERGED}); }
    if (isnew(5)) run(5, 6, 0); else k_gemm<EpiOut><<<dim3(D / 64, S / 64), 256, 0, stream>>>(MERGED, D, WOUT, D, D, EpiOut{x, g_mlp, out, X1G, SSQ1});
    if (isnew(6)) run(6, 7, 0); else k_gemm<EpiUp><<<dim3(FF / 64, S / 64), 256, 0, stream>>>(X1G, D, WUP, D, D, EpiUp{SSQ1, HB});
    if (isnew(7)) run(7, 8, 0); else k_gemm<EpiDn><<<dim3(D / 64, S / 64), 256, 0, stream>>>(HB, FF, WDN, FF, FF, EpiDn{out, SSQ2});
    if (isnew(8)) run(8, 9, 0); else k_final<<<S, 256, 0, stream>>>(out, SSQ2, g_fin);
}
```

```cpp
#include <hip/hip_runtime.h>
#include <cstdio>
#include <cstdint>

typedef unsigned short bf16;
constexpr int S = 8192, D = 2048, NH = 8, HD = 128, MW = 1024, FF = 8192, DIN = 10248, NZ = 10240;
constexpr float EPS = 1e-6f;
constexpr float LOG2E = 1.4426950408889634f;
constexpr float C2 = 0.08838834764831845f * 1.4426950408889634f;
constexpr double FIX = 4294967296.0;

constexpr size_t MiB = 1u << 20;
constexpr size_t WS_CTL = 0, CTL_ZERO_BYTES = 1 * MiB;
constexpr size_t CT_SSQ1 = 64 * 1024, CT_SSQ2 = 128 * 1024, CT_KMEAN = 256 * 1024;
constexpr size_t CT_MISC = 192 * 1024;
constexpr int CW_BAR = 4096;
constexpr size_t WS_FLOG = 1 * MiB, WS_CBN = WS_FLOG + 256 * 1024, WS_SEL = WS_CBN + 256 * 1024, WS_ALI = WS_SEL;
constexpr size_t WS_WIN = 2 * MiB, WS_WA = 42 * MiB, WS_WB = 46 * MiB, WS_WOUT = 50 * MiB, WS_WUP = 58 * MiB, WS_WDN = 90 * MiB;
constexpr size_t WS_XN = 122 * MiB, WS_MERGED = WS_XN;
constexpr size_t WS_LIST = WS_XN, WS_LSE = WS_XN + 8 * MiB, WS_BLK = WS_XN + 9 * MiB;
constexpr float PRUNE_T = 40.0f;
constexpr size_t WS_QKV = 154 * MiB, WS_SIG = 250 * MiB, WS_END = 314 * MiB;
constexpr size_t WS_AM = 2 * MiB, WS_AF = 18 * MiB, WS_X1G = 2 * MiB, WS_H = 154 * MiB;
constexpr size_t QKV_T = (size_t)NH * S * HD;

__device__ __forceinline__ float bf2f(bf16 v) { return __uint_as_float((unsigned)v << 16); }
__device__ __forceinline__ float wave_sum(float v) {
#pragma unroll
    for (int o = 1; o < 64; o <<= 1) v += __shfl_xor(v, o);
    return v;
}
__device__ __forceinline__ float wave_max(float v) {
#pragma unroll
    for (int o = 1; o < 64; o <<= 1) v = fmaxf(v, __shfl_xor(v, o));
    return v;
}
namespace pg8 {
#define PG8_LAS __attribute__((address_space(3)))
typedef unsigned short bf16_t;
typedef short bf16x8 __attribute__((ext_vector_type(8)));
typedef float f32x4 __attribute__((ext_vector_type(4)));
typedef unsigned u32x4 __attribute__((ext_vector_type(4)));
constexpr int BM = 256, BK = 64, HALF = 128, HTB = HALF * BK * 2  , STAGE_BYTES = 8 * HTB, NXCD = 8, WGM = 8;

__host__ __device__ __forceinline__ int lds_byte(int r, int c) { const int st = (r >> 4) * 2 + (c >> 5), rr = r & 15, cc = c & 31, ob = rr * 64 + cc * 2; return st * 1024 + (ob ^ (((ob >> 9) & 1) << 5)); }
__host__ __device__ __forceinline__ void stage_rc(int b, int& R, int& C) { const int st = b / 1024, sb = b % 1024, swz = sb ^ (((sb >> 9) & 1) << 5); R = (st >> 1) * 16 + swz / 64; C = (st & 1) * 32 + (swz % 64) / 2; }
__host__ __device__ __forceinline__ int perm32(int rho) { const int n = rho >> 4, i = rho & 15; return 8 * (i >> 2) + 4 * n + (i & 3); }

struct Unit { int pm, pn, seg; };
struct Gemm { const bf16_t* A0; const bf16_t* A1; const bf16_t* B0; const bf16_t* B1; int K; };

struct StaticOrder {
    int nM, nN, nwg, G, c;
    __host__ __device__ void init(int M, int N, int G_, int c_) { nM = M / BM; nN = N / BM; nwg = nM * nN; G = G_; c = c_; }
    __host__ __device__ bool next(int i, Unit& u) const {
        const long L = (long)i * G + c; if (L >= nwg) return false;
        int wgid = (int)L; { const int q = nwg / NXCD, r = nwg % NXCD, xcd = wgid % NXCD, off = wgid / NXCD; wgid = (xcd < r ? xcd * (q + 1) : r * (q + 1) + (xcd - r) * q) + off; }
        const int nig = WGM * nN, gid = wgid / nig, fm = gid * WGM, gsz = (nM - fm) < WGM ? (nM - fm) : WGM;
        u.pm = fm + ((wgid % nig) % gsz); u.pn = (wgid % nig) / gsz; u.seg = 0; return true;
    }
    __device__ __forceinline__ void a_ready(const Unit&) const {}
    __device__ __forceinline__ void done(const Unit&) const {}
};

typedef float f32x2_t __attribute__((ext_vector_type(2))); typedef __bf16 bf16x2_t __attribute__((ext_vector_type(2)));
__device__ __forceinline__ unsigned cvt_pk_bf16(float lo, float hi) { f32x2_t v = {lo, hi}; bf16x2_t b = __builtin_convertvector(v, bf16x2_t); return __builtin_bit_cast(unsigned, b); }
typedef unsigned u32x2 __attribute__((ext_vector_type(2)));
__device__ __forceinline__ float sigmoidf_fast(float v) { return __builtin_amdgcn_rcpf(1.0f + __builtin_amdgcn_exp2f(-v * LOG2E)); }
__device__ __forceinline__ void unpack8(const u32x4 w, float (&f)[8]) {
    f[0] = __uint_as_float(w.x << 16); f[1] = __uint_as_float(w.x & 0xffff0000u); f[2] = __uint_as_float(w.y << 16); f[3] = __uint_as_float(w.y & 0xffff0000u);
    f[4] = __uint_as_float(w.z << 16); f[5] = __uint_as_float(w.z & 0xffff0000u); f[6] = __uint_as_float(w.w << 16); f[7] = __uint_as_float(w.w & 0xffff0000u);
}
struct EpiIn {
    static constexpr bool PERM = true, AFTER_DRAIN = false, TWO_SEG = false;
    bf16_t* qkv; bf16_t* sig; float* km;
    __device__ __forceinline__ void operator()(const f32x4 (&acc)[2][2][4][2], const Unit& u, int wr, int wc, int fr, int fq) const {
        const int row0 = u.pm * BM + wr * 64 + fr;
        if (u.pn < 24) {
            const int ti = u.pn >> 2; const float sc = (ti == 0 || ti == 3) ? C2 : 1.0f;
#pragma unroll
            for (int bj = 0; bj < 2; ++bj) { const int head = 2 * (u.pn & 3) + bj; bf16_t* base = qkv + ((size_t)(ti * 8 + head) * S) * HD + wc * 32 + 8 * fq;
#pragma unroll
                for (int ai = 0; ai < 2; ++ai)
#pragma unroll
                    for (int m = 0; m < 4; ++m) { const f32x4 v0 = acc[ai][bj][m][0] * sc, v1 = acc[ai][bj][m][1] * sc;
                        u32x4 w; w.x = cvt_pk_bf16(v0[0], v0[1]); w.y = cvt_pk_bf16(v0[2], v0[3]); w.z = cvt_pk_bf16(v1[0], v1[1]); w.w = cvt_pk_bf16(v1[2], v1[3]);
                        *(u32x4*)(base + (size_t)(row0 + ai * HALF + m * 16) * HD) = w; } }
            if (ti == 1) {
#pragma unroll
                for (int bj = 0; bj < 2; ++bj)
#pragma unroll
                    for (int n = 0; n < 2; ++n) { f32x4 s = acc[0][bj][0][n];
#pragma unroll
                        for (int ai = 0; ai < 2; ++ai)
#pragma unroll
                            for (int m = 0; m < 4; ++m) if (ai + m) s += acc[ai][bj][m][n];
#pragma unroll
                        for (int e = 0; e < 4; ++e) { float v = s[e]; v += __shfl_xor(v, 1); v += __shfl_xor(v, 2); v += __shfl_xor(v, 4); v += __shfl_xor(v, 8);
                            if (fr == 0) atomicAdd(km + ((size_t)(2 * (u.pn & 3) + bj) * 32 + u.pm) * HD + wc * 32 + 8 * fq + 4 * n + e, v); } }
            }
        } else {
            const int gi = (u.pn - 24) >> 3, colt = ((u.pn - 24) & 7) * BM;
            bf16_t* base = sig + (size_t)gi * S * D + colt + wc * 32 + 8 * fq;
#pragma unroll
            for (int ai = 0; ai < 2; ++ai)
#pragma unroll
                for (int m = 0; m < 4; ++m) { bf16_t* rowp = base + (size_t)(row0 + ai * HALF + m * 16) * D;
#pragma unroll
                    for (int bj = 0; bj < 2; ++bj) { const f32x4 v0 = acc[ai][bj][m][0], v1 = acc[ai][bj][m][1];
                        u32x4 w; w.x = cvt_pk_bf16(sigmoidf_fast(v0[0]), sigmoidf_fast(v0[1])); w.y = cvt_pk_bf16(sigmoidf_fast(v0[2]), sigmoidf_fast(v0[3]));
                        w.z = cvt_pk_bf16(sigmoidf_fast(v1[0]), sigmoidf_fast(v1[1])); w.w = cvt_pk_bf16(sigmoidf_fast(v1[2]), sigmoidf_fast(v1[3]));
                        *(u32x4*)(rowp + bj * HALF) = w; } }
        }
    }
};
struct EpiProj {
    static constexpr bool PERM = true, AFTER_DRAIN = false, TWO_SEG = true;
    const bf16_t* sig; bf16_t* merged;
    __device__ __forceinline__ void operator()(f32x4 (&acc)[2][2][4][2], const Unit& u, int wr, int wc, int fr, int fq) const {
        const int row0 = u.pm * BM + wr * 64 + fr, col0 = u.pn * BM + wc * 32 + 8 * fq;
#pragma unroll
        for (int ai = 0; ai < 2; ++ai)
#pragma unroll
            for (int m = 0; m < 4; ++m) { const size_t off = (size_t)(row0 + ai * HALF + m * 16) * D + col0;
#pragma unroll
                for (int bj = 0; bj < 2; ++bj) {
                    float fb[8]; unpack8(*(const u32x4*)(sig + (size_t)S * D + off + bj * HALF), fb);
#pragma unroll
                    for (int e = 0; e < 8; ++e) fb[e] = fmaxf(fb[e], 1e-30f);
                    if (u.seg == 0) { float fa[8]; unpack8(*(const u32x4*)(sig + off + bj * HALF), fa);
#pragma unroll
                        for (int e = 0; e < 4; ++e) { acc[ai][bj][m][0][e] *= fa[e] * __builtin_amdgcn_rcpf(fb[e]); acc[ai][bj][m][1][e] *= fa[4 + e] * __builtin_amdgcn_rcpf(fb[4 + e]); } }
                    else { const f32x4 v0 = acc[ai][bj][m][0], v1 = acc[ai][bj][m][1];
                        u32x4 w; w.x = cvt_pk_bf16(v0[0] * fb[0], v0[1] * fb[1]); w.y = cvt_pk_bf16(v0[2] * fb[2], v0[3] * fb[3]); w.z = cvt_pk_bf16(v1[0] * fb[4], v1[1] * fb[5]); w.w = cvt_pk_bf16(v1[2] * fb[6], v1[3] * fb[7]);
                        *(u32x4*)(merged + off + bj * HALF) = w; } }
                asm volatile("" ::: "memory"); }
    }
};
struct EpiRes {
    static constexpr bool PERM = false, AFTER_DRAIN = false, TWO_SEG = false;
    const float* x; const float* g; float* out; bf16_t* xg; unsigned long long* ssq;
    __device__ __forceinline__ void operator()(const f32x4 (&acc)[2][2][4][2], const Unit& u, int wr, int wc, int fr, int fq) const {
        const int row0 = u.pm * BM + wr * 64 + fr, col0 = u.pn * BM + wc * 32 + 4 * fq;
        f32x4 gv[2][2];
#pragma unroll
        for (int bj = 0; bj < 2; ++bj)
#pragma unroll
            for (int n = 0; n < 2; ++n) gv[bj][n] = g ? *(const f32x4*)(g + col0 + bj * HALF + n * 16) : (f32x4){1.f, 1.f, 1.f, 1.f};
#pragma unroll
        for (int ai = 0; ai < 2; ++ai)
#pragma unroll
            for (int m = 0; m < 4; ++m) { const int row = row0 + ai * HALF + m * 16; const size_t off = (size_t)row * D + col0; float ss = 0.f;
#pragma unroll
                for (int bj = 0; bj < 2; ++bj)
#pragma unroll
                    for (int n = 0; n < 2; ++n) { const size_t o = off + bj * HALF + n * 16; const f32x4 y = *(const f32x4*)(x + o) + acc[ai][bj][m][n]; *(f32x4*)(out + o) = y;
                        ss += (y[0] * y[0] + y[1] * y[1]) + (y[2] * y[2] + y[3] * y[3]);
                        if (g) { const f32x4 z = y * gv[bj][n]; u32x2 w; w.x = cvt_pk_bf16(z[0], z[1]); w.y = cvt_pk_bf16(z[2], z[3]); *(u32x2*)(xg + o) = w; } }
                ss += __shfl_xor(ss, 16); ss += __shfl_xor(ss, 32);
                if (fq == 0) atomicAdd(ssq + row, (unsigned long long)((double)ss * FIX));
                asm volatile("" ::: "memory"); }
    }
};
struct EpiUp {
    static constexpr bool PERM = true, AFTER_DRAIN = false, TWO_SEG = false;
    const unsigned long long* ssq; bf16_t* h;
    __device__ __forceinline__ void operator()(const f32x4 (&acc)[2][2][4][2], const Unit& u, int wr, int wc, int fr, int fq) const {
        const int row0 = u.pm * BM + wr * 64 + fr, col0 = u.pn * BM + wc * 32 + 8 * fq;
#pragma unroll
        for (int ai = 0; ai < 2; ++ai)
#pragma unroll
            for (int m = 0; m < 4; ++m) { const int row = row0 + ai * HALF + m * 16;
                const float r2 = 1.0f / ((float)((double)ssq[row] * (1.0 / FIX)) * (1.0f / D) + EPS);
#pragma unroll
                for (int bj = 0; bj < 2; ++bj) { f32x4 v0 = acc[ai][bj][m][0], v1 = acc[ai][bj][m][1];
#pragma unroll
                    for (int e = 0; e < 4; ++e) { const float a = fmaxf(v0[e], 0.f), b = fmaxf(v1[e], 0.f); v0[e] = a * a * r2; v1[e] = b * b * r2; }
                    u32x4 w; w.x = cvt_pk_bf16(v0[0], v0[1]); w.y = cvt_pk_bf16(v0[2], v0[3]); w.z = cvt_pk_bf16(v1[0], v1[1]); w.w = cvt_pk_bf16(v1[2], v1[3]);
                    *(u32x4*)(h + (size_t)row * FF + col0 + bj * HALF) = w; } }
    }
};
struct TwoSegOrder {
    StaticOrder so;
    __host__ __device__ bool next(int i, Unit& u) const { if (!so.next(i >> 1, u)) return false; u.seg = i & 1; return true; }
    __device__ __forceinline__ void a_ready(const Unit&) const {}
    __device__ __forceinline__ void done(const Unit&) const {}
};

template <class Epi, class Sched, bool ALIGN_EPI = false, bool SP2 = false>
__device__ __forceinline__ void gemm_phase(PG8_LAS unsigned char* lds, const Gemm g, const Sched& S, const Epi& E) {
    const int tid = threadIdx.x, wid = __builtin_amdgcn_readfirstlane(tid >> 6), lane = tid & 63, wr = wid >> 2, wc = wid & 3, fr = lane & 15, fq = lane >> 4;
    const int K = g.K, nt = K / BK;
    unsigned voffA[2], voffB[2];
#pragma unroll
    for (int i = 0; i < 2; ++i) { int R, C; stage_rc(tid * 16 + i * 8192, R, C); const int Rb = Epi::PERM ? ((R & ~31) + perm32(R & 31)) : R;
        voffA[i] = (unsigned)(R * K + C) * 2u; voffB[i] = (unsigned)(Rb * K + C) * 2u; }
    const size_t kstep = (size_t)(BK * 2);
    const size_t hstep = (size_t)HALF * K * 2;
    const size_t tstep = 2 * hstep;
    const unsigned ldsw = (unsigned)wid * 1024u;
    const int aoff = lds_byte(wr * 64 + fr, fq * 8), boff = lds_byte(wc * 32 + fr, fq * 8);
#define PG8_SA(b, h) (((b) * 2 + (h)) * HTB)
#define PG8_SB(b, h) ((4 + (b) * 2 + (h)) * HTB)
#define PG8_STAGE(bufoff, gbase, voff) do { _Pragma("unroll") for (int _i = 0; _i < 2; ++_i) \
        __builtin_amdgcn_global_load_lds((const unsigned*)((const char*)(gbase) + (voff)[_i]), (PG8_LAS unsigned*)(lds + (bufoff) + ldsw + _i * 8192), 16, 0, 0); } while (0)
#define PG8_LDA(dst, b, h) do { _Pragma("unroll") for (int m = 0; m < 4; ++m) _Pragma("unroll") for (int k = 0; k < 2; ++k) dst[m][k] = *(const PG8_LAS bf16x8*)(lds + PG8_SA(b, h) + aoff + m * 2048 + k * 1024); } while (0)
#define PG8_LDB(dst, b, h) do { _Pragma("unroll") for (int n = 0; n < 2; ++n) _Pragma("unroll") for (int k = 0; k < 2; ++k) dst[n][k] = *(const PG8_LAS bf16x8*)(lds + PG8_SB(b, h) + boff + n * 2048 + k * 1024); } while (0)
#define PG8_MMA(ai, bj, At, Bt) do { __builtin_amdgcn_s_setprio(1); _Pragma("unroll") for (int m = 0; m < 4; ++m) _Pragma("unroll") for (int n = 0; n < 2; ++n) _Pragma("unroll") for (int k = 0; k < 2; ++k) \
        acc[ai][bj][m][n] = __builtin_amdgcn_mfma_f32_16x16x32_bf16(Bt[n][k], At[m][k], acc[ai][bj][m][n], 0, 0, 0); __builtin_amdgcn_s_setprio(0); } while (0)
#define PG8_WAIT_V(n) asm volatile("s_waitcnt vmcnt(" #n ")" ::: "memory")
#define PG8_WAIT_L(n) asm volatile("s_waitcnt lgkmcnt(" #n ")" ::: "memory")
#define PG8_BAR __builtin_amdgcn_s_barrier()
#define PG8_SCHED __builtin_amdgcn_sched_barrier(0)
    Unit cur, nxt; int ui = 0;
    if (!S.next(0, cur)) return;
    f32x4 acc[2][2][4][2];
#pragma unroll
    for (int a = 0; a < 2; ++a)
#pragma unroll
        for (int b = 0; b < 2; ++b)
#pragma unroll
            for (int m = 0; m < 4; ++m)
#pragma unroll
                for (int n = 0; n < 2; ++n) acc[a][b][m][n] = (f32x4){0.f, 0.f, 0.f, 0.f};
    bf16x8 At[4][2], B0[2][2], B1[2][2];
    const char* cA = (const char*)(cur.seg ? g.A1 : g.A0) + (size_t)cur.pm * tstep; const char* cB = (const char*)(cur.seg ? g.B1 : g.B0) + (size_t)cur.pn * tstep;
    S.a_ready(cur);
    if constexpr (SP2) {
        PG8_STAGE(PG8_SB(0, 0), cB, voffB); PG8_STAGE(PG8_SB(0, 1), cB + hstep, voffB); PG8_STAGE(PG8_SA(0, 0), cA, voffA); PG8_STAGE(PG8_SA(0, 1), cA + hstep, voffA);
        if (wr == 1) PG8_BAR;
        PG8_WAIT_V(2); PG8_BAR;
        PG8_STAGE(PG8_SB(1, 0), cB + kstep, voffB); PG8_STAGE(PG8_SA(1, 0), cA + kstep, voffA); PG8_STAGE(PG8_SB(1, 1), cB + hstep + kstep, voffB);
        PG8_WAIT_V(6); PG8_BAR;
    } else {
        PG8_STAGE(PG8_SB(0, 0), cB, voffB); PG8_STAGE(PG8_SA(0, 0), cA, voffA); PG8_STAGE(PG8_SB(0, 1), cB + hstep, voffB); PG8_STAGE(PG8_SA(0, 1), cA + hstep, voffA);
        if (wr == 1) PG8_BAR;
        PG8_WAIT_V(4); PG8_BAR;
        PG8_STAGE(PG8_SB(1, 0), cB + kstep, voffB); PG8_STAGE(PG8_SA(1, 0), cA + kstep, voffA); PG8_STAGE(PG8_SB(1, 1), cB + hstep + kstep, voffB);
        PG8_WAIT_V(6); PG8_BAR;
    }
    for (;;) {
        const bool has_next = S.next(ui + 1, nxt);
        const char* nA = has_next ? (const char*)(nxt.seg ? g.A1 : g.A0) + (size_t)nxt.pm * tstep : cA; const char* nB = has_next ? (const char*)(nxt.seg ? g.B1 : g.B0) + (size_t)nxt.pn * tstep : cB;
        for (int t = 0; t < nt; t += 2) {
            const bool last = (t == nt - 2);
            const char* a1 = cA + (size_t)(t + 1) * kstep;
            const char* a2 = last ? nA : cA + (size_t)(t + 2) * kstep; const char* b2 = last ? nB : cB + (size_t)(t + 2) * kstep;
            const char* a3 = a2 + kstep; const char* b3 = b2 + kstep;
            if (last && has_next) S.a_ready(nxt);
            if constexpr (SP2) {
            PG8_LDB(B0, 0, 0); PG8_LDB(B1, 0, 1); PG8_SCHED; PG8_LDA(At, 0, 0); PG8_STAGE(PG8_SA(1, 1), a1 + hstep, voffA);
            PG8_WAIT_V(8); PG8_WAIT_L(0); PG8_BAR; PG8_MMA(0, 0, At, B0); PG8_MMA(0, 1, At, B1); PG8_BAR; PG8_SCHED;
            PG8_LDA(At, 0, 1); PG8_STAGE(PG8_SB(0, 0), b2, voffB); PG8_STAGE(PG8_SB(0, 1), b2 + hstep, voffB); PG8_STAGE(PG8_SA(0, 0), a2, voffA);
            PG8_WAIT_V(8); PG8_WAIT_L(0); PG8_BAR; PG8_MMA(1, 0, At, B0); PG8_MMA(1, 1, At, B1); PG8_BAR; PG8_SCHED;
            PG8_LDB(B0, 1, 0); PG8_LDB(B1, 1, 1); PG8_SCHED; PG8_LDA(At, 1, 0); PG8_STAGE(PG8_SA(0, 1), a2 + hstep, voffA);
            PG8_WAIT_V(8); PG8_WAIT_L(0); PG8_BAR; PG8_MMA(0, 0, At, B0); PG8_MMA(0, 1, At, B1); PG8_BAR; PG8_SCHED;
            PG8_LDA(At, 1, 1); PG8_STAGE(PG8_SB(1, 0), b3, voffB); PG8_STAGE(PG8_SB(1, 1), b3 + hstep, voffB); PG8_STAGE(PG8_SA(1, 0), a3, voffA);
            PG8_WAIT_V(8); PG8_WAIT_L(0); PG8_BAR; PG8_MMA(1, 0, At, B0); PG8_MMA(1, 1, At, B1); PG8_BAR; PG8_SCHED;
            } else {
            PG8_LDB(B0, 0, 0); PG8_SCHED; PG8_LDA(At, 0, 0); PG8_STAGE(PG8_SA(1, 1), a1 + hstep, voffA);
            PG8_WAIT_L(8); PG8_BAR; PG8_WAIT_L(0); PG8_MMA(0, 0, At, B0); PG8_BAR; PG8_SCHED;
            PG8_LDB(B1, 0, 1); PG8_STAGE(PG8_SB(0, 0), b2, voffB);
            PG8_BAR; PG8_WAIT_L(0); PG8_MMA(0, 1, At, B1); PG8_BAR;
            PG8_LDA(At, 0, 1); PG8_STAGE(PG8_SA(0, 0), a2, voffA);
            PG8_BAR; PG8_WAIT_L(0); PG8_MMA(1, 0, At, B0); PG8_BAR; PG8_SCHED;
            PG8_STAGE(PG8_SB(0, 1), b2 + hstep, voffB);
            PG8_WAIT_V(6); PG8_BAR; PG8_MMA(1, 1, At, B1); PG8_BAR;
            PG8_LDB(B0, 1, 0); PG8_SCHED; PG8_LDA(At, 1, 0); PG8_STAGE(PG8_SA(0, 1), a2 + hstep, voffA);
            PG8_WAIT_L(8); PG8_BAR; PG8_WAIT_L(0); PG8_MMA(0, 0, At, B0); PG8_BAR; PG8_SCHED;
            PG8_LDB(B1, 1, 1); PG8_STAGE(PG8_SB(1, 0), b3, voffB);
            PG8_BAR; PG8_WAIT_L(0); PG8_MMA(0, 1, At, B1); PG8_BAR;
            PG8_LDA(At, 1, 1); PG8_STAGE(PG8_SA(1, 0), a3, voffA);
            PG8_BAR; PG8_WAIT_L(0); PG8_MMA(1, 0, At, B0); PG8_BAR; PG8_SCHED;
            PG8_STAGE(PG8_SB(1, 1), b3 + hstep, voffB);
            PG8_WAIT_V(6); PG8_BAR; PG8_MMA(1, 1, At, B1); PG8_BAR;
            }
        }
        if constexpr (ALIGN_EPI) { if (wr == 0) PG8_BAR; }
        if constexpr (!Epi::AFTER_DRAIN) { E(acc, cur, wr, wc, fr, fq); S.done(cur); }
        if (!has_next) break;
        if (!(Epi::TWO_SEG && cur.seg == 0))
#pragma unroll
        for (int a = 0; a < 2; ++a)
#pragma unroll
            for (int b = 0; b < 2; ++b)
#pragma unroll
                for (int m = 0; m < 4; ++m)
#pragma unroll
                    for (int n = 0; n < 2; ++n) acc[a][b][m][n] = (f32x4){0.f, 0.f, 0.f, 0.f};
        cur = nxt; cA = nA; cB = nB; ++ui;
        if constexpr (ALIGN_EPI) { if (wr == 1) PG8_BAR; }
    }
    PG8_WAIT_V(0);
    if constexpr (!ALIGN_EPI) { if (wr == 0) PG8_BAR; }
    PG8_BAR;
    if constexpr (Epi::AFTER_DRAIN) { E.fused(acc, cur, wr, wc, fr, fq, lds, wid, lane); S.done(cur); }
#undef PG8_SA
#undef PG8_SB
#undef PG8_STAGE
#undef PG8_LDA
#undef PG8_LDB
#undef PG8_MMA
#undef PG8_WAIT_V
#undef PG8_WAIT_L
#undef PG8_BAR
#undef PG8_SCHED
}
}

#define GAS __attribute__((address_space(1)))
#define LAS __attribute__((address_space(3)))
typedef unsigned short bf16;
typedef unsigned v4u __attribute__((ext_vector_type(4)));
typedef float f32x4 __attribute__((ext_vector_type(4)));
typedef short bf16x8 __attribute__((ext_vector_type(8)));
typedef GAS unsigned gu32;
typedef GAS unsigned long long gu64;
#define RLX_AGENT __ATOMIC_RELAXED, __HIP_MEMORY_SCOPE_AGENT
#define LDS_WAIT() asm volatile("s_waitcnt lgkmcnt(0)" ::: "memory")
#define VM_WAIT() asm volatile("s_waitcnt vmcnt(0)" ::: "memory")
__device__ __forceinline__ unsigned long long rt() { return __builtin_amdgcn_s_memrealtime(); }
__device__ __forceinline__ unsigned f2bf(float f) { unsigned u = __builtin_bit_cast(unsigned, f); return (u + 0x7fffu + ((u >> 16) & 1u)) >> 16; }
__device__ __forceinline__ unsigned pk2(float lo, float hi) { return f2bf(lo) | (f2bf(hi) << 16); }

#define XB_TMO      128
#define XB_XCNT(j)  (256  + 64 * (j))
#define XB_XSUB(j)  (1280 + 64 * (j))
#define XB_XGEN(j)  (2304 + 64 * (j))
#define XB_TOP      3328
#define XB_TOPGEN   3392
#define XCD_BAR_WORDS 3456
#define XB_SPIN_CAP (1u << 18)

__device__ __forceinline__ unsigned xb_ld(unsigned* p)              { return __hip_atomic_load(p, __ATOMIC_RELAXED, __HIP_MEMORY_SCOPE_AGENT); }
__device__ __forceinline__ unsigned xb_add(unsigned* p, unsigned v) { return __hip_atomic_fetch_add(p, v, __ATOMIC_RELAXED, __HIP_MEMORY_SCOPE_AGENT); }
__device__ __forceinline__ unsigned xb_xcc_id() { return (unsigned)__builtin_amdgcn_s_getreg((3 << 11) | 20) & 0xFu; }
#define XB_SPIN(cond, bar) do { unsigned _sp = 0; while (cond) { __builtin_amdgcn_s_sleep(1); \
    if ((++_sp & 255u) == 0u) { if (xb_ld(&(bar)[XB_TMO])) break; if (_sp > XB_SPIN_CAP) { atomicAdd(&(bar)[XB_TMO], 1u); break; } } } } while (0)

struct XcdBarrier {
    unsigned* bar; unsigned x;
    volatile LAS unsigned* st;
};

__device__ __forceinline__ XcdBarrier xcd_barrier_post(unsigned* bar, volatile LAS unsigned* st) {
    XcdBarrier b; b.bar = bar; b.x = xb_xcc_id(); b.st = st;
    if (threadIdx.x == 0) (void)xb_add(&bar[XB_XCNT(b.x)], 1u);
    return b;
}
__device__ __forceinline__ void xcd_barrier_complete(unsigned* bar, unsigned x, unsigned& nloc, unsigned& nx) {
    const unsigned G = gridDim.x * gridDim.y * gridDim.z;
    unsigned sum, cnt, mine, sp = 0u;
    for (;;) {
        sum = 0u; cnt = 0u; mine = 0u;
#pragma unroll
        for (unsigned j = 0; j < 16; ++j) { const unsigned c = xb_ld(&bar[XB_XCNT(j)]); sum += c; cnt += (c > 0u) ? 1u : 0u; mine = (j == x) ? c : mine; }
        if (sum == G) break;
        __builtin_amdgcn_s_sleep(1);
        if ((++sp & 255u) == 0u) { if (xb_ld(&bar[XB_TMO])) break; if (sp > XB_SPIN_CAP) { atomicAdd(&bar[XB_TMO], 1u); break; } }
    }
    nloc = mine > 0u ? mine : 1u; nx = cnt > 0u ? cnt : 1u;
}

__device__ __forceinline__ void xcd_barrier(const XcdBarrier& b) {
    asm volatile("s_waitcnt vmcnt(0)" ::: "memory");
    __syncthreads();
    if (threadIdx.x == 0) {
        unsigned* bar = b.bar;
        __builtin_amdgcn_s_waitcnt(0);
        unsigned nloc = b.st[0], nx = b.st[1];
        if (nloc == 0u) { xcd_barrier_complete(bar, b.x, nloc, nx); b.st[0] = nloc; b.st[1] = nx; }
        const unsigned old = xb_add(&bar[XB_XSUB(b.x)], 1u);
        const unsigned gen = old / nloc;
        if (old + 1u == (gen + 1u) * nloc) {
            __builtin_amdgcn_fence(__ATOMIC_RELEASE, "agent");
            asm volatile("s_waitcnt vmcnt(0)" ::: "memory");
            const unsigned og = xb_add(&bar[XB_TOP], 1u);
            const unsigned tg = og / nx;
            if (og + 1u == (tg + 1u) * nx) xb_add(&bar[XB_TOPGEN], 1u);
            else XB_SPIN(xb_ld(&bar[XB_TOPGEN]) == tg, bar);
            __builtin_amdgcn_fence(__ATOMIC_ACQUIRE, "agent");
            xb_add(&bar[XB_XGEN(b.x)], 1u);
            asm volatile("s_waitcnt vmcnt(0)" ::: "memory");
        } else {
            XB_SPIN(xb_ld(&bar[XB_XGEN(b.x)]) == gen, bar);
            __builtin_amdgcn_fence(__ATOMIC_ACQUIRE, "agent");
            asm volatile("s_waitcnt vmcnt(0)" ::: "memory");
        }
    }
    __syncthreads();
}

namespace att {
#define ALDS __attribute__((address_space(3)))
typedef ALDS char* lptr; typedef const ALDS char* clptr;
typedef short bf16x8 __attribute__((ext_vector_type(8)));
typedef short s16x4 __attribute__((ext_vector_type(4)));
typedef float f32x16 __attribute__((ext_vector_type(16)));
typedef float f32x4 __attribute__((ext_vector_type(4)));
typedef unsigned u32x4 __attribute__((ext_vector_type(4)));
constexpr int NW = 8, QBLK = 32, KVBLK = 64, QB = 256, DH = 128, LDO = 1024;
constexpr int SHM_V = KVBLK * DH * 2, SHM_K = KVBLK * DH * 2;
constexpr int OFF_WS = 2 * SHM_V + 2 * SHM_K, OFF_BIAS = OFF_WS + NW * 64 * 4, ATT_LDS_BYTES = OFF_BIAS + 2 * 256;
constexpr float THR2 = 11.5f;
#define KSWZ(row, colB) ((row) * 256 + ((colB) ^ (((row) & 7) << 4)))
#define SBAR() __builtin_amdgcn_sched_barrier(0)
__device__ __forceinline__ int v_st(int k, int c) { const int kk = (k & ~0xC) | ((k & 4) << 1) | ((k & 8) >> 1); return ((kk >> 3) * 4 + (c >> 5)) * 512 + ((kk & 7) * 32 + (c & 31)) * 2; }
__device__ __forceinline__ int v_rd_base(int lane) { return ((lane & 3) << 3) | (((lane >> 2) & 3) << 6) | (((lane >> 4) & 1) << 5) | (((lane >> 5) & 1) << 8); }
constexpr int v_rd_off(int d0, int ks, int half) { return d0 * 512 + ks * 4096 + half * 2048; }
__device__ __forceinline__ int crow(int r, int hi) { return (r & 3) + 8 * (r >> 2) + 4 * hi; }
typedef float f32x2_t __attribute__((ext_vector_type(2))); typedef __bf16 bf16x2_t __attribute__((ext_vector_type(2)));
__device__ __forceinline__ unsigned cvtpk(float lo, float hi) { f32x2_t v = {lo, hi}; bf16x2_t b = __builtin_convertvector(v, bf16x2_t); return __builtin_bit_cast(unsigned, b); }
__device__ __forceinline__ bf16x8 ld16(const void* ubase, unsigned voff) { return *reinterpret_cast<const bf16x8*>((const char*)ubase + voff); }
__device__ __forceinline__ void mask_tile(f32x16& p0, f32x16& p1, int dq) {
    const float NEG = -__builtin_inff();
#pragma unroll
    for (int r = 0; r < 16; ++r) { const int c = (r & 3) + 8 * (r >> 2); if (c > dq) p0[r] = NEG; if (c + 32 > dq) p1[r] = NEG; }
}
__device__ __forceinline__ void partialSM(f32x16& p0, f32x16& p1, float& m_reg, float& alpha, bool off) {
    float pmax = p0[0];
#pragma unroll
    for (int r = 1; r < 16; ++r) pmax = fmaxf(pmax, p0[r]);
#pragma unroll
    for (int r = 0; r < 16; ++r) pmax = fmaxf(pmax, p1[r]);
    { auto rr = __builtin_amdgcn_permlane32_swap(__float_as_uint(pmax), __float_as_uint(pmax), false, false);
      pmax = fmaxf(__uint_as_float(rr[0]), __uint_as_float(rr[1])); }
    if (off) pmax = -__builtin_inff();
    float mn;
    if (__builtin_expect(__all((pmax - m_reg) <= THR2), 1)) { mn = m_reg; alpha = 1.f; }
    else { mn = fmaxf(m_reg, pmax); alpha = __builtin_amdgcn_exp2f(m_reg - mn); m_reg = mn; }
    const float mnL = off ? __builtin_inff() : mn;
#pragma unroll
    for (int r = 0; r < 16; ++r) p0[r] = p0[r] - mnL;
#pragma unroll
    for (int r = 0; r < 16; ++r) p1[r] = p1[r] - mnL;
#pragma unroll
    for (int r = 0; r < 16; ++r) p0[r] = __builtin_amdgcn_exp2f(p0[r]);
}
__device__ __forceinline__ void finishSM(f32x16& p0, f32x16& p1, float alpha, float& l_reg, bf16x8& pa0, bf16x8& pa1, bf16x8& pa2, bf16x8& pa3) {
#pragma unroll
    for (int r = 0; r < 16; ++r) p1[r] = __builtin_amdgcn_exp2f(p1[r]);
    float ps = 0;
#pragma unroll
    for (int r = 0; r < 16; ++r) ps += p0[r];
#pragma unroll
    for (int r = 0; r < 16; ++r) ps += p1[r];
    { auto rr = __builtin_amdgcn_permlane32_swap(__float_as_uint(ps), __float_as_uint(ps), false, false);
      ps = __uint_as_float(rr[0]) + __uint_as_float(rr[1]); }
    l_reg = l_reg * alpha + ps;
#define PK4(P, B_, OUT) do { unsigned a0 = cvtpk(P[B_+0], P[B_+1]), a1 = cvtpk(P[B_+2], P[B_+3]);                          \
        unsigned b0 = cvtpk(P[B_+4], P[B_+5]), b1 = cvtpk(P[B_+6], P[B_+7]);                                             \
        auto r0 = __builtin_amdgcn_permlane32_swap(a0, b0, false, false); auto r1 = __builtin_amdgcn_permlane32_swap(a1, b1, false, false); \
        u32x4 w = {r0[0], r1[0], r0[1], r1[1]}; OUT = *reinterpret_cast<bf16x8*>(&w); } while (0)
    PK4(p0, 0, pa0); PK4(p0, 8, pa1); PK4(p1, 0, pa2); PK4(p1, 8, pa3);
#undef PK4
}
template <int KB>
__device__ __forceinline__ void qkt(f32x16& p0, f32x16& p1, clptr K_lds, clptr bias_lds, int r32, int hi, const bf16x8* qr, float bref) {
    const ALDS f32x4* bp = (const ALDS f32x4*)(bias_lds + KB * 256 + hi * 16);
    { const f32x4 a = bp[0] - bref, b = bp[2] - bref, c = bp[4] - bref, d = bp[6] - bref, e = bp[8] - bref, f = bp[10] - bref, g = bp[12] - bref, h = bp[14] - bref;
      p0 = (f32x16){a[0], a[1], a[2], a[3], b[0], b[1], b[2], b[3], c[0], c[1], c[2], c[3], d[0], d[1], d[2], d[3]};
      p1 = (f32x16){e[0], e[1], e[2], e[3], f[0], f[1], f[2], f[3], g[0], g[1], g[2], g[3], h[0], h[1], h[2], h[3]}; }
    clptr kb[4];
#pragma unroll
    for (int dd = 0; dd < 4; ++dd) kb[dd] = K_lds + KB * SHM_K + KSWZ(r32, (dd * 16 + hi * 8) * 2);
#pragma unroll
    for (int d0 = 0; d0 < 8; ++d0) { clptr a = kb[d0 & 3] + (d0 >> 2) * 128;
        bf16x8 b0 = *(const ALDS bf16x8*)(a);
        bf16x8 b1 = *(const ALDS bf16x8*)(a + 32 * 256);
        p0 = __builtin_amdgcn_mfma_f32_32x32x16_bf16(b0, qr[d0], p0, 0, 0, 0);
        p1 = __builtin_amdgcn_mfma_f32_32x32x16_bf16(b1, qr[d0], p1, 0, 0, 0);
        if (d0 == 3) SBAR(); }
}
template <int VB>
__device__ __forceinline__ void pv_tile(f32x16* o, int vb0, bf16x8 pa0, bf16x8 pa1, bf16x8 pa2, bf16x8 pa3) {
#define TRRD(dst, off) asm volatile("ds_read_b64_tr_b16 %0, %1 offset:%2" : "=&v"(dst) : "v"(vb0), "i"(off) : "memory")
#define PV_D0(d0) do { s16x4 l0, l1, l2, l3, h0, h1, h2, h3; constexpr int b_ = VB * SHM_V + v_rd_off(d0, 0, 0); \
        TRRD(l0, b_); TRRD(h0, b_ + 2048); TRRD(l1, b_ + 4096); TRRD(h1, b_ + 6144); TRRD(l2, b_ + 8192); TRRD(h2, b_ + 10240); TRRD(l3, b_ + 12288); TRRD(h3, b_ + 14336); \
        asm volatile("s_waitcnt lgkmcnt(0)" ::: "memory"); SBAR();   \
        o[d0] = __builtin_amdgcn_mfma_f32_32x32x16_bf16(pa0, (bf16x8){l0[0], l0[1], l0[2], l0[3], h0[0], h0[1], h0[2], h0[3]}, o[d0], 0, 0, 0);   \
        o[d0] = __builtin_amdgcn_mfma_f32_32x32x16_bf16(pa1, (bf16x8){l1[0], l1[1], l1[2], l1[3], h1[0], h1[1], h1[2], h1[3]}, o[d0], 0, 0, 0);   \
        o[d0] = __builtin_amdgcn_mfma_f32_32x32x16_bf16(pa2, (bf16x8){l2[0], l2[1], l2[2], l2[3], h2[0], h2[1], h2[2], h2[3]}, o[d0], 0, 0, 0);   \
        o[d0] = __builtin_amdgcn_mfma_f32_32x32x16_bf16(pa3, (bf16x8){l3[0], l3[1], l3[2], l3[3], h3[0], h3[1], h3[2], h3[3]}, o[d0], 0, 0, 0); } while (0)
    PV_D0(0); PV_D0(1); PV_D0(2); PV_D0(3);
#undef PV_D0
#undef TRRD
}
struct BlockRef { int kind, h, P0, j_lo, j_hi; float blin, bref; };
__device__ __forceinline__ const bf16* bq(const unsigned char* ws, const BlockRef& B) { return (const bf16*)(ws + WS_QKV) + (size_t)(B.kind ? 0 : 3) * QKV_T + ((size_t)B.h * S + (B.kind ? 0 : B.P0)) * HD; }
__device__ __forceinline__ const bf16* bk(const unsigned char* ws, const BlockRef& B) { return (const bf16*)(ws + WS_QKV) + (size_t)(B.kind ? 1 : 4) * QKV_T + (size_t)B.h * S * HD; }
__device__ __forceinline__ const bf16* bv(const unsigned char* ws, const BlockRef& B) { return (const bf16*)(ws + WS_QKV) + (size_t)(B.kind ? 2 : 5) * QKV_T + (size_t)B.h * S * HD; }
__device__ __forceinline__ const float* bb(const unsigned char* ws, const BlockRef& B) { return (const float*)(ws + (B.kind ? WS_ALI : WS_CBN)) + (size_t)B.h * S; }
__device__ __forceinline__ bf16* bo(unsigned char* ws, const BlockRef& B) { return (bf16*)(ws + (B.kind ? WS_AM : WS_AF)) + (size_t)B.P0 * MW + B.h * HD; }
#define VMW() asm volatile("s_waitcnt vmcnt(0)" ::: "memory")
#define DMA_TILE(buf, k0) do { const char* kb_ = (const char*)bk(ws, cur) + (size_t)(k0) * (DH * 2); const char* vb_ = (const char*)bv(ws, cur) + (size_t)(k0) * (DH * 2);  \
        _Pragma("unroll") for (int i_ = 0; i_ < 2; ++i_) {                                                                                   \
            __builtin_amdgcn_global_load_lds((const unsigned*)(kb_ + (i_ ? koff1 : koff0)), (ALDS unsigned*)(K_lds + (buf) * SHM_K + pbase + i_ * 1024), 16, 0, 0);   \
            __builtin_amdgcn_global_load_lds((const unsigned*)(vb_ + (i_ ? voff1 : voff0)), (ALDS unsigned*)(V_lds + (buf) * SHM_V + pbase + i_ * 1024), 16, 0, 0); } \
        if (wid == 0) __builtin_amdgcn_global_load_lds((const unsigned*)(bb(ws, cur) + (k0) + lane), (ALDS unsigned*)(B_lds + (buf) * 256), 4, 0, 0); } while (0)
template <int KIND>
__device__ __forceinline__ void attn_block(unsigned char* ws, const BlockRef& cur, lptr lds, unsigned ent, bf16* part) {
    const int tid = threadIdx.x, wid = __builtin_amdgcn_readfirstlane(tid >> 6), lane = tid & 63, r32 = lane & 31, hi = lane >> 5;
    const int j_lo = cur.j_lo, NT = cur.j_hi - cur.j_lo;
    const int qlo = (KIND == 0 || cur.P0 >= 0) ? cur.P0 + wid * QBLK : 0x3fffffff, qm = qlo + r32 - 4 * hi;
    lptr V_lds = lds; lptr K_lds = lds + 2 * SHM_V; lptr B_lds = lds + OFF_BIAS;
    ALDS float* wsf = (ALDS float*)(lds + OFF_WS) + wid * 64; ALDS float* li_l = wsf; ALDS float* al_l = wsf + 32;
    const int vb0 = (int)(unsigned)(size_t)V_lds + v_rd_base(lane);
    const unsigned qoff = KIND == 0 ? (unsigned)((wid * QBLK + r32) * DH + hi * 8) * 2u : (unsigned)((ent & 0x1fffu) * DH + hi * 8) * 2u;
    const int pbase = wid * 2048;
    const int krow0 = 8 * wid + (lane >> 4), krow1 = krow0 + 4;
    const unsigned koff0 = (unsigned)(krow0 * 256 + (((lane & 15) ^ (krow0 & 7)) << 4)), koff1 = (unsigned)(krow1 * 256 + (((lane & 15) ^ (krow1 & 7)) << 4));
    const int st0 = 4 * wid + (lane >> 5), st1 = st0 + 2;
    const int kk0 = (st0 >> 2) * 8 + ((lane & 31) >> 2), kk1 = (st1 >> 2) * 8 + ((lane & 31) >> 2);
    const int kv0 = (kk0 & ~0xC) | ((kk0 & 4) << 1) | ((kk0 & 8) >> 1), kv1 = (kk1 & ~0xC) | ((kk1 & 4) << 1) | ((kk1 & 8) >> 1);
    const unsigned voff0 = (unsigned)(kv0 * 256 + ((st0 & 3) * 32 + (lane & 3) * 8) * 2), voff1 = (unsigned)(kv1 * 256 + ((st1 & 3) * 32 + (lane & 3) * 8) * 2);
    bf16x8 qr[8];
#pragma unroll
    for (int d0 = 0; d0 < 8; ++d0) qr[d0] = ld16((const char*)bq(ws, cur) + d0 * 32, qoff);
    DMA_TILE(0, j_lo * KVBLK);
    VMW();
    __syncthreads();
    float m_reg = -1e30f, l_reg = 0; f32x16 o[4] = {};
    const float bref = cur.bref;
#define RESC(a) do { if (__any((a) < 1.f)) { if (hi == 0) al_l[r32] = (a); asm volatile("s_waitcnt lgkmcnt(0)" ::: "memory");              \
                     _Pragma("unroll") for (int d_ = 0; d_ < 4; ++d_) _Pragma("unroll") for (int r = 0; r < 16; ++r) o[d_][r] *= al_l[crow(r, hi)]; } } while (0)
#define KBASE(t) ((j_lo + (t)) * KVBLK)
#define MASKT(P0_, P1_, t) do { const int kb_m = KBASE(t); if (kb_m + KVBLK - 1 > qlo) mask_tile(P0_, P1_, qm - kb_m); } while (0)
#define TILE(t, BUF) do { f32x16 p0, p1; float al; bf16x8 pa0, pa1, pa2, pa3;                                              \
        if ((t) + 1 < NT) { DMA_TILE((BUF) ^ 1, KBASE((t) + 1)); } SBAR();                                                \
        qkt<BUF>(p0, p1, K_lds, B_lds, r32, hi, qr, bref);                                                                 \
        MASKT(p0, p1, (t)); partialSM(p0, p1, m_reg, al, false); RESC(al);                                                 \
        finishSM(p0, p1, al, l_reg, pa0, pa1, pa2, pa3); SBAR();                                                          \
        pv_tile<BUF>(o, vb0, pa0, pa1, pa2, pa3);                                                                          \
        VMW(); __syncthreads(); } while (0)
    int t = 0;
    for (; t + 1 < NT; t += 2) { TILE(t, 0); TILE(t + 1, 1); }
    if (t < NT) TILE(t, 0);
    if (hi == 0) li_l[r32] = l_reg; asm volatile("s_waitcnt lgkmcnt(0)" ::: "memory");
    float rli[16];
#pragma unroll
    for (int r = 0; r < 16; ++r) rli[r] = __builtin_amdgcn_rcpf(li_l[crow(r, hi)]);
    if constexpr (KIND == 0) {
        const unsigned ooff = (unsigned)((wid * QBLK + 4 * hi) * LDO + r32) * 2u;
#pragma unroll
        for (int r = 0; r < 16; ++r) { const int cr = (r & 3) + 8 * (r >> 2);
#pragma unroll
            for (int d0 = 0; d0 < 4; ++d0) { const float v = o[d0][r] * rli[r]; const float vn = __shfl_xor(v, 1);
                if ((r32 & 1) == 0) *(unsigned*)((char*)bo(ws, cur) + (cr * LDO + d0 * 32) * 2 + ooff) = cvtpk(v, vn); } }
    } else {
        const int slot = (ent >> 16) & 3, tq = ent & 0x1fffu;
        if (hi == 0 && !(ent >> 31))
            ((float*)(ws + WS_LSE))[((size_t)slot * NH + cur.h) * S + tq] = m_reg + __builtin_amdgcn_logf(l_reg) - (cur.blin * (float)tq - cur.bref);
#pragma unroll
        for (int r = 0; r < 16; ++r) { const unsigned er = (unsigned)__shfl((int)ent, crow(r, hi)); const bool st = !(er >> 31) && (r32 & 1) == 0;
            char* dst = (char*)part + ((((size_t)((er >> 16) & 3) * NH + cur.h) * S + (er & 0x1fffu)) * HD + r32) * 2;
#pragma unroll
            for (int d0 = 0; d0 < 4; ++d0) { const float v = o[d0][r] * rli[r]; const float vn = __shfl_xor(v, 1);
                if (st) *(unsigned*)(dst + d0 * 64) = cvtpk(v, vn); } }
    }
    asm volatile("s_waitcnt lgkmcnt(0)" ::: "memory");
#undef RESC
#undef KBASE
#undef MASKT
#undef TILE
}
#undef VMW
#undef DMA_TILE
#undef KSWZ
#undef SBAR
#undef ALDS
}
constexpr int NWAVES = 8;
constexpr int RING_OFF = 0, RING_BYTES = 131072;
constexpr int LDSCTL_OFF = RING_BYTES, MISC_OFF = LDSCTL_OFF + 320;
constexpr int LDS_BYTES = 147456;
#ifndef MK_N_LAUNCHES
#define MK_N_LAUNCHES 1
#endif
constexpr int N_PHASES = 9;

struct Args { const float* in[11]; float* out; unsigned char* ws; int ph_lo, ph_hi, li, pad; };
struct Frame {
    LAS unsigned char* lds; volatile LAS unsigned* MISC; gu32* ctl;
    int tid, lane, wave, vcu, G;
    const Args* a;
};
#define F_IN(i)   (F.a->in[i])
#define F_x       F_IN(0)
#define F_g_mix   F_IN(1)
#define F_w_in    F_IN(2)
#define F_b_forget F_IN(3)
#define F_w_pa    F_IN(4)
#define F_w_pb    F_IN(5)
#define F_w_out   F_IN(6)
#define F_g_mlp   F_IN(7)
#define F_w_up    F_IN(8)
#define F_w_dn    F_IN(9)
#define F_g_fin   F_IN(10)
#define F_out     (F.a->out)
#define F_WS(off) (F.a->ws + (off))
#define F_WIN  ((bf16*)F_WS(WS_WIN))
#define F_WA   ((bf16*)F_WS(WS_WA))
#define F_WB   ((bf16*)F_WS(WS_WB))
#define F_WOUT ((bf16*)F_WS(WS_WOUT))
#define F_WUP  ((bf16*)F_WS(WS_WUP))
#define F_WDN  ((bf16*)F_WS(WS_WDN))
#define F_XN   ((bf16*)F_WS(WS_XN))
#define F_MERGED ((bf16*)F_WS(WS_MERGED))
#define F_QKV  ((bf16*)F_WS(WS_QKV))
#define F_SIG  ((bf16*)F_WS(WS_SIG))
#define F_AM   ((bf16*)F_WS(WS_AM))
#define F_AF   ((bf16*)F_WS(WS_AF))
#define F_X1G  ((bf16*)F_WS(WS_X1G))
#define F_HB   ((bf16*)F_WS(WS_H))
#define F_FLOG ((float*)F_WS(WS_FLOG))
#define F_CBN  ((float*)F_WS(WS_CBN))
#define F_SEL  ((unsigned*)F_WS(WS_SEL))
#define F_SSQ1 ((unsigned long long*)F_WS(CT_SSQ1))
#define F_SSQ2 ((unsigned long long*)F_WS(CT_SSQ2))
#define F_KM   ((float*)F_WS(CT_KMEAN))
struct TItem { const float* src; bf16* dst; int Nsrc, K; };
constexpr int I_IN = (D / 64) * (NZ / 64), I_P = (MW / 64) * (D / 64), I_O = (D / 64) * (D / 64), I_U = (D / 64) * (FF / 64), I_D = (FF / 64) * (D / 64), I_ALL = I_IN + 2 * I_P + I_O + I_U + I_D;
__device__ __forceinline__ bool p0_item(const Frame& F, int it, TItem& T) {
    const float* W; bf16* WT; int K, Nsrc, Ndst, skip = 0;
    if (it < I_IN) { W = F_w_in; WT = F_WIN; K = D; Nsrc = DIN; Ndst = NZ; skip = 8; }
    else if ((it -= I_IN) < I_P) { W = F_w_pa; WT = F_WA; K = MW; Nsrc = D; Ndst = D; }
    else if ((it -= I_P) < I_P) { W = F_w_pb; WT = F_WB; K = MW; Nsrc = D; Ndst = D; }
    else if ((it -= I_P) < I_O) { W = F_w_out; WT = F_WOUT; K = D; Nsrc = D; Ndst = D; }
    else if ((it -= I_O) < I_U) { W = F_w_up; WT = F_WUP; K = D; Nsrc = FF; Ndst = FF; }
    else if ((it -= I_U) < I_D) { W = F_w_dn; WT = F_WDN; K = FF; Nsrc = D; Ndst = D; }
    else return false;
    const int nblk = Ndst / 64, kb = it / nblk, nb = it % nblk, k0 = 64 * kb, n0 = 64 * nb, s0 = (skip && n0 >= 6144) ? n0 + skip : n0;
    T.src = W + (size_t)k0 * Nsrc + s0; T.dst = WT + (size_t)n0 * K + k0; T.Nsrc = Nsrc; T.K = K; return true;
}
template <int NI>
__device__ __forceinline__ void p0_load(const TItem& T, int lane, f32x4 (&v)[2 * NI], int i0) {
    const float* p = T.src + (size_t)(2 * (lane >> 4) + 8 * i0) * T.Nsrc + 4 * (lane & 15);
#pragma unroll
    for (int i = 0; i < NI; ++i) { v[2 * i] = *(const GAS f32x4*)(p + (size_t)(8 * i) * T.Nsrc); v[2 * i + 1] = *(const GAS f32x4*)(p + (size_t)(8 * i + 1) * T.Nsrc); }
}
template <int NI>
__device__ __forceinline__ void p0_write(int lane, const f32x4 (&v)[2 * NI], int i0, LAS unsigned char* tile) {
    const int nq = lane & 15, kq = lane >> 4;
#pragma unroll
    for (int i = 0; i < NI; ++i)
#pragma unroll
        for (int e = 0; e < 4; ++e) { const int n = 4 * nq + e;
            *(LAS unsigned*)(tile + n * 128 + (((i0 + i) ^ (nq & 7)) << 4) + kq * 4) = pk2(v[2 * i][e], v[2 * i + 1][e]); }
}
__device__ __forceinline__ void p0_store(const TItem& T, int lane, LAS unsigned char* tile) {
    LDS_WAIT(); asm volatile("" ::: "memory");
    const int c = lane & 7;
#pragma unroll
    for (int j = 0; j < 8; ++j) { const int n = (lane >> 3) + 8 * j;
        const v4u o = *(const LAS v4u*)(tile + n * 128 + ((c ^ ((n >> 2) & 7)) << 4));
        *(GAS v4u*)(T.dst + (size_t)n * T.K + 8 * c) = o; }
    LDS_WAIT(); asm volatile("" ::: "memory");
}
__device__ __forceinline__ void p0_emit(const TItem& T, int lane, const f32x4 (&v)[16], LAS unsigned char* tile) { p0_write<8>(lane, v, 0, tile); p0_store(T, lane, tile); }
__device__ __forceinline__ void p0_prologue(Frame& F) {
    LAS unsigned char* tile = F.lds + RING_OFF + F.wave * 8192;
    const int gw = F.vcu * NWAVES + F.wave, NGW = F.G * NWAVES;
    {   TItem cur, nxt; f32x4 va[16], vb[16];
        bool have = gw < I_IN && p0_item(F, gw, cur); int it = gw;
        if (have) p0_load<8>(cur, F.lane, va, 0);
        while (have) {
            bool hn = it + NGW < I_IN && p0_item(F, it + NGW, nxt); if (hn) p0_load<8>(nxt, F.lane, vb, 0);
            p0_emit(cur, F.lane, va, tile);
            if (!hn) break;
            it += 2 * NGW; have = it < I_IN && p0_item(F, it, cur); if (have) p0_load<8>(cur, F.lane, va, 0);
            p0_emit(nxt, F.lane, vb, tile);
        }
    }
    __syncthreads();
    LAS float* wfg = (LAS float*)(F.lds + RING_OFF);
    for (int idx = F.tid; idx < 8 * D; idx += NWAVES * 64) { const int k = idx >> 3, h = idx & 7; wfg[h * D + k] = F_w_in[(size_t)k * DIN + 6144 + h] * F_g_mix[k]; }
    __syncthreads();
    f32x4 gv[8];
#pragma unroll
    for (int j = 0; j < 8; ++j) gv[j] = *((const GAS f32x4*)F_g_mix + F.lane + 64 * j);
    for (int m = gw; m < S; m += NGW) {
        const GAS f32x4* xr = (const GAS f32x4*)(F_x + (size_t)m * D) + F.lane;
        f32x4 v[8]; float ss = 0.f;
#pragma unroll
        for (int j = 0; j < 8; ++j) { v[j] = xr[64 * j]; ss += (v[j].x * v[j].x + v[j].y * v[j].y) + (v[j].z * v[j].z + v[j].w * v[j].w); }
        const float rstd = 1.0f / sqrtf(wave_sum(ss) * (1.0f / D) + EPS);
        GAS unsigned long long* o8 = (GAS unsigned long long*)(F_XN + (size_t)m * D) + F.lane;
#pragma unroll
        for (int j = 0; j < 8; ++j) { const f32x4 hn = v[j] * gv[j] * rstd; o8[64 * j] = (unsigned long long)pk2(hn.x, hn.y) | ((unsigned long long)pk2(hn.z, hn.w) << 32); }
        float fl = 0.f;
#pragma unroll 1
        for (int h = 0; h < 8; ++h) { float a = 0.f;
#pragma unroll
            for (int j = 0; j < 8; ++j) { const f32x4 w = *((const LAS f32x4*)(wfg + h * D) + F.lane + 64 * j); a += (v[j].x * w.x + v[j].y * w.y) + (v[j].z * w.z + v[j].w * w.w); }
            a = wave_sum(a) * rstd; if (F.lane == h) fl = a; }
        if (F.lane < 8) F_FLOG[(size_t)m * 8 + F.lane] = fl;
    }
}
struct Top3 { float v0, v1, v2; int i0, i1, i2; };
__device__ __forceinline__ void top3_insert(Top3& T, float v, int n) {
    const bool b0 = v > T.v0 || (v == T.v0 && n < T.i0), b1 = v > T.v1 || (v == T.v1 && n < T.i1), b2 = v > T.v2 || (v == T.v2 && n < T.i2);
    if (b0) { T.v2 = T.v1; T.i2 = T.i1; T.v1 = T.v0; T.i1 = T.i0; T.v0 = v; T.i0 = n; }
    else if (b1) { T.v2 = T.v1; T.i2 = T.i1; T.v1 = v; T.i1 = n; }
    else if (b2) { T.v2 = v; T.i2 = n; }
}
__device__ __forceinline__ void route_item(int h, int b, const bf16* __restrict__ qa, const float* km, unsigned* cnt, unsigned* __restrict__ list, float* __restrict__ lse, LAS float* lds  ) {
    const int tid = threadIdx.x;
    LAS float* kml = lds; LAS float* xv = lds + 4096; LAS int* xi = (LAS int*)(lds + 4096 + 768); LAS int* hist = (LAS int*)(lds + 4096 + 1536); LAS int* basel = hist + 32;
    for (int i = tid; i < 4096; i += 512) kml[i] = __hip_atomic_load(km + (size_t)h * 4096 + i, __ATOMIC_RELAXED, __HIP_MEMORY_SCOPE_AGENT);
    if (tid < 32) hist[tid] = 0;
    __syncthreads();
    const int q = tid & 255, par = tid >> 8, t = b * 256 + q;
    float g[16];
#pragma unroll
    for (int i = 0; i < 16; ++i) g[i] = 0.f;
    const bf16* qrow = qa + ((size_t)h * S + t) * HD;
    for (int d0 = 0; d0 < 128; d0 += 8) {
        const uint4 raw = *(const uint4*)(qrow + d0);
        float qv[8]; qv[0] = __uint_as_float(raw.x << 16); qv[1] = __uint_as_float(raw.x & 0xffff0000u); qv[2] = __uint_as_float(raw.y << 16); qv[3] = __uint_as_float(raw.y & 0xffff0000u);
        qv[4] = __uint_as_float(raw.z << 16); qv[5] = __uint_as_float(raw.z & 0xffff0000u); qv[6] = __uint_as_float(raw.w << 16); qv[7] = __uint_as_float(raw.w & 0xffff0000u);
#pragma unroll
        for (int i = 0; i < 16; ++i) { const LAS float* kr = kml + (2 * i + par) * 128 + d0;
#pragma unroll
            for (int e = 0; e < 8; ++e) g[i] += qv[e] * kr[e]; }
    }
    Top3 T; T.v0 = T.v1 = T.v2 = -INFINITY; T.i0 = T.i1 = T.i2 = 1 << 20;
#pragma unroll
    for (int i = 0; i < 16; ++i) { const int n = 2 * i + par; if (n < b) top3_insert(T, g[i], n); }
    if (par == 1) { xv[q] = T.v0; xv[256 + q] = T.v1; xv[512 + q] = T.v2; xi[q] = T.i0; xi[256 + q] = T.i1; xi[512 + q] = T.i2; }
    __syncthreads();
    int o0 = 0, o1 = 0, o2 = 0; bool ok0 = false, ok1 = false, ok2 = false;
    if (par == 0) {
        top3_insert(T, xv[q], xi[q]); top3_insert(T, xv[256 + q], xi[256 + q]); top3_insert(T, xv[512 + q], xi[512 + q]);
        ok0 = T.v0 > -INFINITY; ok1 = T.v1 > -INFINITY; ok2 = T.v2 > -INFINITY;
        if (ok0) o0 = __hip_atomic_fetch_add(hist + T.i0, 1, __ATOMIC_RELAXED, __HIP_MEMORY_SCOPE_WORKGROUP);
        if (ok1) o1 = __hip_atomic_fetch_add(hist + T.i1, 1, __ATOMIC_RELAXED, __HIP_MEMORY_SCOPE_WORKGROUP);
        if (ok2) o2 = __hip_atomic_fetch_add(hist + T.i2, 1, __ATOMIC_RELAXED, __HIP_MEMORY_SCOPE_WORKGROUP);
    }
    __syncthreads();
    if (tid < 32) { const int c = hist[tid]; basel[tid] = c ? (int)__hip_atomic_fetch_add(cnt + h * 32 + tid, (unsigned)c, __ATOMIC_RELAXED, __HIP_MEMORY_SCOPE_AGENT) : 0; }
    __syncthreads();
    if (par == 0) {
        if (ok0) list[(size_t)(h * 32 + T.i0) * S + basel[T.i0] + o0] = (unsigned)t | (1u << 16); else lse[((size_t)1 * NH + h) * S + t] = -INFINITY;
        if (ok1) list[(size_t)(h * 32 + T.i1) * S + basel[T.i1] + o1] = (unsigned)t | (2u << 16); else lse[((size_t)2 * NH + h) * S + t] = -INFINITY;
        if (ok2) list[(size_t)(h * 32 + T.i2) * S + basel[T.i2] + o2] = (unsigned)t | (3u << 16); else lse[((size_t)3 * NH + h) * S + t] = -INFINITY;
    }
    __syncthreads();
}
__device__ __forceinline__ void fox_stats(int h, int b, const bf16* __restrict__ qb, const bf16* __restrict__ kb, float* __restrict__ blk, unsigned* kn2, LAS float* lds  ) {
    const int tid = threadIdx.x, row = tid & 255, half = tid >> 8, lane = tid & 63, wid = tid >> 6;
    const bf16* qr = qb + ((size_t)h * S + b * 256 + row) * HD + half * 64; const bf16* kr = kb + ((size_t)h * S + b * 256 + row) * HD + half * 64;
    float q2 = 0.f, dq = 0.f, k2 = 0.f;
#pragma unroll
    for (int d0 = 0; d0 < 64; d0 += 8) { const uint4 a = *(const uint4*)(qr + d0), c = *(const uint4*)(kr + d0);
        const unsigned aw[4] = {a.x, a.y, a.z, a.w}, cw[4] = {c.x, c.y, c.z, c.w};
#pragma unroll
        for (int e = 0; e < 4; ++e) { const float a0 = __uint_as_float(aw[e] << 16), a1 = __uint_as_float(aw[e] & 0xffff0000u), c0 = __uint_as_float(cw[e] << 16), c1 = __uint_as_float(cw[e] & 0xffff0000u);
            q2 += a0 * a0 + a1 * a1; dq += a0 * c0 + a1 * c1; k2 += c0 * c0 + c1 * c1; } }
    if (half == 1) { lds[row] = q2; lds[256 + row] = dq; lds[512 + row] = k2; }
    __syncthreads();
    if (half == 0) { q2 += lds[row]; dq += lds[256 + row]; k2 += lds[512 + row];
        q2 = wave_max(q2); k2 = wave_max(k2); dq = -wave_max(-dq);
        if (lane == 0) { lds[768 + wid] = q2; lds[776 + wid] = dq; lds[784 + wid] = k2; } }
    __syncthreads();
    if (tid == 0) { float a = lds[768], d = lds[776], c = lds[784];
        for (int w = 1; w < 4; ++w) { a = fmaxf(a, lds[768 + w]); d = fminf(d, lds[776 + w]); c = fmaxf(c, lds[784 + w]); }
        blk[h * 32 + b] = a; blk[256 + h * 32 + b] = d; atomicMax(kn2 + h, __float_as_uint(c)); }
    __syncthreads();
}
__device__ __forceinline__ void scan_head(int h, const float* __restrict__ flog, const float* __restrict__ bfg, float* __restrict__ cbn, float* __restrict__ ali, LAS double* lds  ) {
    const int tid = threadIdx.x; const float bh = bfg[h];
    float lf[16]; double s = 0.0;
#pragma unroll
    for (int i = 0; i < 16; ++i) { const float z = flog[(size_t)(tid * 16 + i) * 8 + h] + bh; lf[i] = fminf(z, 0.f) - log1pf(expf(-fabsf(z))); s += (double)lf[i]; }
    lds[tid] = s; __syncthreads();
    for (int o = 1; o < 512; o <<= 1) { const double v = tid >= o ? lds[tid - o] : 0.0; __syncthreads(); lds[tid] += v; __syncthreads(); }
    double run = tid ? lds[tid - 1] : 0.0;
#pragma unroll
    for (int i = 0; i < 16; ++i) { run += (double)lf[i]; cbn[(size_t)h * S + tid * 16 + i] = (float)(-run * 1.4426950408889634); ali[(size_t)h * S + tid * 16 + i] = exp2f(-(float)(h + 1)) * LOG2E * (float)(tid * 16 + i); }
    __syncthreads();
}
constexpr int NCSTEP_ITEMS = I_ALL - I_IN;
__device__ __forceinline__ void conv_step(const Frame& F, int s) {
    const int gw = F.vcu * NWAVES + F.wave, NGW = F.G * NWAVES; TItem T; f32x4 v[8];
    __builtin_amdgcn_sched_barrier(0); asm volatile("" ::: "memory");
    int ln = F.lane; asm volatile("" : "+v"(ln));
    if (p0_item(F, I_IN + s * NGW + gw, T)) { LAS unsigned char* tile = F.lds + RING_OFF + F.wave * 8192;
        p0_load<4>(T, ln, v, 0); p0_write<4>(ln, v, 0, tile); asm volatile("" ::: "memory"); p0_load<4>(T, ln, v, 4); p0_write<4>(ln, v, 4, tile); p0_store(T, ln, tile); }
    __builtin_amdgcn_sched_barrier(0); asm volatile("" ::: "memory");
}
__device__ __forceinline__ att::BlockRef p3_fox_ref(const Frame& F, int item) {
    att::BlockRef r; r.kind = 0; r.h = item >> 5; const int qb = item & 31; r.P0 = qb * 256; r.j_hi = (r.P0 + 256) / 64; r.blin = 0.f;
    const float* cb = F_CBN + (size_t)r.h * S; r.bref = cb[r.P0];
    const float* blk = (const float*)F_WS(WS_BLK); const float kn2 = __uint_as_float(((const unsigned*)F_WS(CT_MISC))[256 + r.h]);
    const float bound = sqrtf(blk[r.h * 32 + qb] * kn2) - blk[256 + r.h * 32 + qb] + PRUNE_T;
    const int nb = r.P0 / 64, l0 = F.lane, l1 = F.lane + 64;
    const bool s0 = l0 < nb && (r.bref - cb[l0 < nb ? 64 * l0 + 63 : 0]) >= bound, s1 = l1 < nb && (r.bref - cb[l1 < nb ? 64 * l1 + 63 : 0]) >= bound;
    r.j_lo = __builtin_amdgcn_readfirstlane(__popcll(__ballot(s0)) + __popcll(__ballot(s1)));
    return r;
}
__global__ void __launch_bounds__(NWAVES * 64, 2) skel_fwd(Args args) {
    extern __shared__ __attribute__((aligned(16))) unsigned char lds[];
    Frame F;
    F.lds = (LAS unsigned char*)lds; F.MISC = (volatile LAS unsigned*)(F.lds + MISC_OFF);
    F.tid = threadIdx.x; F.lane = F.tid & 63; F.wave = __builtin_amdgcn_readfirstlane(F.tid >> 6);
    F.G = gridDim.x; { const int bx = blockIdx.x; F.vcu = (F.G % 8 == 0) ? (bx % 8) * (F.G / 8) + bx / 8 : bx; }
    F.a = &args; F.ctl = (gu32*)(args.ws + WS_CTL);
    for (int u = F.tid; u < (LDS_BYTES - LDSCTL_OFF) / 4; u += NWAVES * 64) ((LAS unsigned*)(F.lds + LDSCTL_OFF))[u] = 0u;
    __syncthreads();
    const int lo = args.ph_lo, hi = args.ph_hi;
    const bool use_bar = (hi - lo) > 1;
    XcdBarrier bar; bar.bar = (unsigned*)(F.ctl + CW_BAR) + args.li * XCD_BAR_WORDS; bar.x = 0; bar.st = nullptr;
    if (use_bar) bar = xcd_barrier_post((unsigned*)(F.ctl + CW_BAR) + args.li * XCD_BAR_WORDS, F.MISC + 8);
#ifdef ONLY_PHASE
#define IN(k) ((k) == ONLY_PHASE && lo <= (k) && (k) < hi)
#else
#define IN(k) (lo <= (k) && (k) < hi)
#endif
#define BOTH(k) (IN(k) && IN((k) + 1))
#define GRID_BAR() xcd_barrier(bar)
#ifndef REP_PHASE
#define REP_PHASE -1
#endif
#define REPS(k) for (int rep_ = 0; rep_ < ((k) == REP_PHASE ? 2 : 1); ++rep_)

    if (IN(0)) REPS(0) { p0_prologue(F); if (BOTH(0)) GRID_BAR(); }
    if (IN(1)) REPS(1) {
        pg8::Gemm g{F_XN, F_XN, F_WIN, F_WIN, D}; pg8::StaticOrder So; So.init(S, NZ, F.G, (int)blockIdx.x);
        pg8::EpiIn E{F_QKV, F_SIG, F_KM};
        pg8::gemm_phase<pg8::EpiIn, pg8::StaticOrder, true, true>(F.lds + RING_OFF, g, So, E);
        if (BOTH(1)) GRID_BAR();
    }
    if (IN(2)) REPS(2) {
        for (int it = blockIdx.x; it < NH * 32; it += F.G) { route_item(it >> 5, it & 31, F_QKV, F_KM, (unsigned*)F_WS(CT_MISC), (unsigned*)F_WS(WS_LIST), (float*)F_WS(WS_LSE), (LAS float*)(F.lds + RING_OFF));
            fox_stats(it >> 5, it & 31, F_QKV + 3 * QKV_T, F_QKV + 4 * QKV_T, (float*)F_WS(WS_BLK), (unsigned*)F_WS(CT_MISC) + 256, (LAS float*)(F.lds + RING_OFF)); }
        for (int h = blockIdx.x; h < NH; h += F.G) scan_head(h, F_FLOG, F_b_forget, F_CBN, (float*)F_WS(WS_ALI), (LAS double*)(F.lds + RING_OFF));
        if (BOTH(2)) GRID_BAR();
    }
    if (IN(3)) {
        const att::lptr alds = (att::lptr)(F.lds + RING_OFF);
        LAS unsigned* pre = (LAS unsigned*)(F.lds + 98304); LAS unsigned* qslot = pre + 264;
        const unsigned* cnt = (const unsigned*)F_WS(CT_MISC);
        { unsigned v = 0; if (F.tid < 256) v = (__hip_atomic_load(cnt + F.tid, __ATOMIC_RELAXED, __HIP_MEMORY_SCOPE_AGENT) + 255u) >> 8;
          unsigned incl = v;
#pragma unroll
          for (int o = 1; o < 64; o <<= 1) { const unsigned u = __shfl_up(incl, o); if (F.lane >= o) incl += u; }
          if (F.tid < 256 && F.lane == 63) qslot[4 + F.wave] = incl;
          __syncthreads();
          if (F.tid < 256) { unsigned off = 0; for (int w = 0; w < F.wave; ++w) off += qslot[4 + w]; pre[F.tid + 1] = off + incl; if (F.tid == 0) pre[0] = 0; }
          __syncthreads(); }
        const unsigned NCH = pre[256];
        int cstep = 0; const int NCS = (NCSTEP_ITEMS + F.G * NWAVES - 1) / (F.G * NWAVES);
        for (int it = F.vcu; it < 256; it += F.G) { const att::BlockRef cur = p3_fox_ref(F, it); __syncthreads(); att::attn_block<0>(F.a->ws, cur, alds, 0u, nullptr); if (cstep < NCS) conv_step(F, cstep++); }
        for (;;) {
            __syncthreads();
            if (F.tid == 0) qslot[0] = __hip_atomic_fetch_add((unsigned*)F_WS(CT_MISC) + 272, 1u, __ATOMIC_RELAXED, __HIP_MEMORY_SCOPE_AGENT);
            __syncthreads();
            const unsigned q = qslot[0];
            if (q >= NCH + 256u) break;
            att::BlockRef cur; cur.kind = 1; unsigned ent; int hn;
            const int row = F.wave * 32 + (F.lane & 31);
            if (q < NCH) { int lo = 0, hi = 256;
                while (hi - lo > 1) { const int mid = (lo + hi) >> 1; if (pre[mid] <= q) lo = mid; else hi = mid; }
                hn = lo; const int c = (int)(q - pre[hn]); const int cv = (int)__hip_atomic_load(cnt + hn, __ATOMIC_RELAXED, __HIP_MEMORY_SCOPE_AGENT);
                const int nrows = (cv - c * 256) < 256 ? (cv - c * 256) : 256, rr = row < nrows ? row : nrows - 1;
                ent = ((const unsigned*)F_WS(WS_LIST))[(size_t)hn * S + c * 256 + rr] | (row >= nrows ? 0x80000000u : 0u); cur.P0 = -1; }
            else { hn = (int)(q - NCH); cur.P0 = (hn & 31) * 256; ent = (unsigned)(cur.P0 + row); }
            cur.h = hn >> 5; const int n = hn & 31; cur.j_lo = 4 * n; cur.j_hi = 4 * n + 4;
            const float slope2 = exp2f(-(float)(cur.h + 1)) * LOG2E; cur.blin = slope2; cur.bref = slope2 * (float)(256 * n);
            att::attn_block<1>(F.a->ws, cur, alds, ent, (bf16*)F_out);
            if (cstep < NCS) conv_step(F, cstep++);
        }
        while (cstep < NCS) conv_step(F, cstep++);
        GRID_BAR();
        {
            const int gw = F.vcu * NWAVES + F.wave, NGW = F.G * NWAVES; const float* lse = (const float*)F_WS(WS_LSE); const bf16* part = (const bf16*)F_out;
            for (int task = gw; task < S * NH / 4; task += NGW) {
                const int pair = task * 4 + (F.lane >> 4), t = pair >> 3, h = pair & 7, sub = F.lane & 15;
                float ls[4], w[4];
#pragma unroll
                for (int j = 0; j < 4; ++j) ls[j] = lse[((size_t)j * NH + h) * S + t];
                const float M = fmaxf(fmaxf(ls[0], ls[1]), fmaxf(ls[2], ls[3])); float W = 0.f;
#pragma unroll
                for (int j = 0; j < 4; ++j) { w[j] = __builtin_amdgcn_exp2f(ls[j] - M); W += w[j]; }
                const float iw = 1.0f / W; float acc[8];
#pragma unroll
                for (int e = 0; e < 8; ++e) acc[e] = 0.f;
#pragma unroll
                for (int j = 0; j < 4; ++j) if (w[j] > 0.f) { const v4u raw = *(const GAS v4u*)(part + (((size_t)j * NH + h) * S + t) * HD + sub * 8); const float wj = w[j] * iw;
                    acc[0] += wj * __uint_as_float(raw.x << 16); acc[1] += wj * __uint_as_float(raw.x & 0xffff0000u); acc[2] += wj * __uint_as_float(raw.y << 16); acc[3] += wj * __uint_as_float(raw.y & 0xffff0000u);
                    acc[4] += wj * __uint_as_float(raw.z << 16); acc[5] += wj * __uint_as_float(raw.z & 0xffff0000u); acc[6] += wj * __uint_as_float(raw.w << 16); acc[7] += wj * __uint_as_float(raw.w & 0xffff0000u); }
                v4u o; o.x = pk2(acc[0], acc[1]); o.y = pk2(acc[2], acc[3]); o.z = pk2(acc[4], acc[5]); o.w = pk2(acc[6], acc[7]);
                *(GAS v4u*)(F_AM + (size_t)t * MW + h * HD + sub * 8) = o;
            }
        }
        if (BOTH(3)) GRID_BAR();
    }
    if (IN(4)) REPS(4) {
        pg8::Gemm g{F_AM, F_AF, F_WA, F_WB, MW}; pg8::TwoSegOrder So; So.so.init(S, D, F.G, (int)blockIdx.x);
        pg8::EpiProj E{F_SIG, F_MERGED};
        pg8::gemm_phase<pg8::EpiProj, pg8::TwoSegOrder, true, true>(F.lds + RING_OFF, g, So, E);
        if (BOTH(4)) GRID_BAR();
    }
    if (IN(5)) {
        pg8::Gemm g{F_MERGED, F_MERGED, F_WOUT, F_WOUT, D}; pg8::StaticOrder So; So.init(S, D, F.G, (int)blockIdx.x);
        pg8::EpiRes E{F_x, F_g_mlp, F_out, F_X1G, F_SSQ1};
        pg8::gemm_phase<pg8::EpiRes, pg8::StaticOrder, true, true>(F.lds + RING_OFF, g, So, E);
        if (BOTH(5)) GRID_BAR();
    }
    if (IN(6)) REPS(6) {
        pg8::Gemm g{F_X1G, F_X1G, F_WUP, F_WUP, D}; pg8::StaticOrder So; So.init(S, FF, F.G, (int)blockIdx.x);
        pg8::EpiUp E{F_SSQ1, F_HB};
        pg8::gemm_phase<pg8::EpiUp, pg8::StaticOrder, true, true>(F.lds + RING_OFF, g, So, E);
        if (BOTH(6)) GRID_BAR();
    }
    if (IN(7)) {
        pg8::Gemm g{F_HB, F_HB, F_WDN, F_WDN, FF}; pg8::StaticOrder So; So.init(S, D, F.G, (int)blockIdx.x);
        pg8::EpiRes E{F_out, nullptr, F_out, nullptr, F_SSQ2};
        pg8::gemm_phase<pg8::EpiRes, pg8::StaticOrder, true, true>(F.lds + RING_OFF, g, So, E);
        if (BOTH(7)) GRID_BAR();
    }
    if (IN(8)) {
        const int gw = F.vcu * NWAVES + F.wave, NGW = F.G * NWAVES;
        f32x4 gv[8];
#pragma unroll
        for (int j = 0; j < 8; ++j) gv[j] = *((const GAS f32x4*)F_g_fin + F.lane + 64 * j);
        for (int m = gw; m < S; m += NGW) {
            const float rstd = 1.0f / sqrtf((float)((double)F_SSQ2[m] * (1.0 / FIX)) * (1.0f / D) + EPS);
            GAS f32x4* xr = (GAS f32x4*)(F_out + (size_t)m * D) + F.lane;
#pragma unroll
            for (int j = 0; j < 8; ++j) xr[64 * j] = xr[64 * j] * gv[j] * rstd;
        }
    }
#undef IN
#undef BOTH
#undef GRID_BAR
}
__global__ void __launch_bounds__(256) k_transpose(const float* __restrict__ W, int K, int Nsrc, int split, int skip, bf16* __restrict__ WT) {
    __shared__ float tile[32][33];
    const int tx = threadIdx.x & 31, ty = threadIdx.x >> 5, n0 = blockIdx.x * 32, k0 = blockIdx.y * 32;
    const int sc = n0 + tx < split ? n0 + tx : n0 + tx + skip;
#pragma unroll
    for (int j = 0; j < 4; ++j) { const int kk = ty + 8 * j; tile[kk][tx] = W[(size_t)(k0 + kk) * Nsrc + sc]; }
    __syncthreads();
#pragma unroll
    for (int j = 0; j < 4; ++j) { const int n = ty + 8 * j; WT[(size_t)(n0 + n) * K + k0 + tx] = f2bf(tile[tx][n]); }
}
__global__ void __launch_bounds__(256) k_norm_x(const float* __restrict__ x, const float* __restrict__ g, const float* __restrict__ w_in, bf16* __restrict__ XN, float* __restrict__ flog) {
    __shared__ float red[4][9];
    const int t = blockIdx.x, tid = threadIdx.x, lane = tid & 63, wid = tid >> 6;
    float v[8]; float ss = 0.f;
#pragma unroll
    for (int j = 0; j < 8; ++j) { v[j] = x[(size_t)t * D + tid + 256 * j]; ss += v[j] * v[j]; }
    ss = wave_sum(ss); if (lane == 0) red[wid][8] = ss; __syncthreads();
    const float rstd = 1.0f / sqrtf((red[0][8] + red[1][8] + red[2][8] + red[3][8]) * (1.0f / D) + EPS);
    float f[8];
#pragma unroll
    for (int h = 0; h < 8; ++h) f[h] = 0.f;
#pragma unroll
    for (int j = 0; j < 8; ++j) { const int k = tid + 256 * j; const float hn = v[j] * rstd * g[k]; XN[(size_t)t * D + k] = f2bf(hn);
#pragma unroll
        for (int h = 0; h < 8; ++h) f[h] += hn * w_in[(size_t)k * DIN + 6144 + h]; }
#pragma unroll
    for (int h = 0; h < 8; ++h) { f[h] = wave_sum(f[h]); if (lane == 0) red[wid][h] = f[h]; }
    __syncthreads();
    if (tid < 8) flog[t * 8 + tid] = red[0][tid] + red[1][tid] + red[2][tid] + red[3][tid];
}
template <class Epi>
__global__ void __launch_bounds__(256) k_gemm(const bf16* __restrict__ A, int lda, const bf16* __restrict__ Bt, int ldb, int K, Epi e) {
    __shared__ float As[16][65], Bs[16][65];
    const int tid = threadIdx.x, tx = tid & 15, ty = tid >> 4, row0 = blockIdx.y * 64, col0 = blockIdx.x * 64;
    float acc[4][4];
#pragma unroll
    for (int i = 0; i < 4; ++i)
#pragma unroll
        for (int j = 0; j < 4; ++j) acc[i][j] = 0.f;
    for (int k0 = 0; k0 < K; k0 += 16) {
#pragma unroll
        for (int i = 0; i < 4; ++i) { const int idx = tid + 256 * i, r = idx >> 4, kk = idx & 15;
            As[kk][r] = bf2f(A[(size_t)(row0 + r) * lda + k0 + kk]); Bs[kk][r] = bf2f(Bt[(size_t)(col0 + r) * ldb + k0 + kk]); }
        __syncthreads();
#pragma unroll
        for (int kk = 0; kk < 16; ++kk) { float a[4], b[4];
#pragma unroll
            for (int i = 0; i < 4; ++i) { a[i] = As[kk][ty * 4 + i]; b[i] = Bs[kk][tx * 4 + i]; }
#pragma unroll
            for (int i = 0; i < 4; ++i)
#pragma unroll
                for (int j = 0; j < 4; ++j) acc[i][j] += a[i] * b[j]; }
        __syncthreads();
    }
#pragma unroll
    for (int i = 0; i < 4; ++i)
#pragma unroll
        for (int j = 0; j < 4; ++j) e(row0 + ty * 4 + i, col0 + tx * 4 + j, acc[i][j]);
}
struct EpiZ { bf16* qkv; bf16* sig;
    __device__ void operator()(int r, int c, float v) const {
        if (c < 6144) { const int ti = c >> 10, hh = (c & 1023) >> 7, d = c & 127; if (ti == 0 || ti == 3) v *= C2; qkv[((size_t)(ti * 8 + hh) * S + r) * HD + d] = f2bf(v); }
        else { const int gi = (c - 6144) >> 11, cc = (c - 6144) & 2047; sig[((size_t)gi * S + r) * D + cc] = f2bf(1.0f / (1.0f + __builtin_amdgcn_exp2f(-v * LOG2E))); }
    } };
struct EpiPa { const bf16* sig; bf16* merged;
    __device__ void operator()(int r, int c, float v) const { merged[(size_t)r * D + c] = f2bf(bf2f(sig[(size_t)r * D + c]) * v); } };
struct EpiPb { const bf16* sig; bf16* merged;
    __device__ void operator()(int r, int c, float v) const { const size_t i = (size_t)r * D + c; merged[i] = f2bf(bf2f(merged[i]) + bf2f(sig[(size_t)S * D + i]) * v); } };
struct EpiOut { const float* x; const float* g; float* x1; bf16* x1g; unsigned long long* ssq;
    __device__ void operator()(int r, int c, float v) const { const size_t i = (size_t)r * D + c; const float y = x[i] + v; x1[i] = y; x1g[i] = f2bf(y * g[c]);
        atomicAdd(ssq + r, (unsigned long long)((double)(y * y) * FIX)); } };
struct EpiUp { const unsigned long long* ssq; bf16* h;
    __device__ void operator()(int r, int c, float v) const { const float r2 = 1.0f / ((float)((double)ssq[r] * (1.0 / FIX)) * (1.0f / D) + EPS); const float u = fmaxf(v, 0.f); h[(size_t)r * FF + c] = f2bf(u * u * r2); } };
struct EpiDn { float* x2; unsigned long long* ssq;
    __device__ void operator()(int r, int c, float v) const { const size_t i = (size_t)r * D + c; const float y = x2[i] + v; x2[i] = y; atomicAdd(ssq + r, (unsigned long long)((double)(y * y) * FIX)); } };

__global__ void __launch_bounds__(128) k_kmean(const bf16* __restrict__ ka, float* __restrict__ km) {
    const int hn = blockIdx.x, h = hn >> 5, n = hn & 31, d = threadIdx.x; float s = 0.f;
    for (int i = 0; i < 256; ++i) s += bf2f(ka[((size_t)h * S + n * 256 + i) * HD + d]);
    km[(size_t)hn * HD + d] = s;
}
struct Top3_v0 { float v0, v1, v2; int i0, i1, i2; };
__device__ __forceinline__ void top3_insert_v0(Top3_v0& T, float v, int n) {
    const bool b0 = v > T.v0 || (v == T.v0 && n < T.i0), b1 = v > T.v1 || (v == T.v1 && n < T.i1), b2 = v > T.v2 || (v == T.v2 && n < T.i2);
    if (b0) { T.v2 = T.v1; T.i2 = T.i1; T.v1 = T.v0; T.i1 = T.i0; T.v0 = v; T.i0 = n; }
    else if (b1) { T.v2 = T.v1; T.i2 = T.i1; T.v1 = v; T.i1 = n; }
    else if (b2) { T.v2 = v; T.i2 = n; }
}
__device__ __forceinline__ void route_item_v0(int h, int b, const bf16* __restrict__ qa, const float* __restrict__ km, unsigned* __restrict__ selmask, float* lds  ) {
    const int tid = threadIdx.x;
    float* kml = lds; float* xv = lds + 4096; int* xi = (int*)(lds + 4096 + 768);
    for (int i = tid; i < 4096; i += 512) kml[i] = km[(size_t)h * 4096 + i];
    __syncthreads();
    const int q = tid & 255, par = tid >> 8, t = b * 256 + q;
    float g[16];
#pragma unroll
    for (int i = 0; i < 16; ++i) g[i] = 0.f;
    const bf16* qrow = qa + ((size_t)h * S + t) * HD;
    for (int d0 = 0; d0 < 128; d0 += 8) {
        const uint4 raw = *(const uint4*)(qrow + d0);
        float qv[8]; qv[0] = __uint_as_float(raw.x << 16); qv[1] = __uint_as_float(raw.x & 0xffff0000u); qv[2] = __uint_as_float(raw.y << 16); qv[3] = __uint_as_float(raw.y & 0xffff0000u);
        qv[4] = __uint_as_float(raw.z << 16); qv[5] = __uint_as_float(raw.z & 0xffff0000u); qv[6] = __uint_as_float(raw.w << 16); qv[7] = __uint_as_float(raw.w & 0xffff0000u);
#pragma unroll
        for (int i = 0; i < 16; ++i) { const float* kr = kml + (2 * i + par) * 128 + d0;
#pragma unroll
            for (int e = 0; e < 8; ++e) g[i] += qv[e] * kr[e]; }
    }
    Top3_v0 T; T.v0 = T.v1 = T.v2 = -INFINITY; T.i0 = T.i1 = T.i2 = 1 << 20;
#pragma unroll
    for (int i = 0; i < 16; ++i) { const int n = 2 * i + par; if (n < b) top3_insert_v0(T, g[i], n); }
    if (par == 1) { xv[q] = T.v0; xv[256 + q] = T.v1; xv[512 + q] = T.v2; xi[q] = T.i0; xi[256 + q] = T.i1; xi[512 + q] = T.i2; }
    __syncthreads();
    if (par == 0) {
        top3_insert_v0(T, xv[q], xi[q]); top3_insert_v0(T, xv[256 + q], xi[256 + q]); top3_insert_v0(T, xv[512 + q], xi[512 + q]);
        unsigned m = 1u << b;
        if (T.v0 > -INFINITY) m |= 1u << T.i0; if (T.v1 > -INFINITY) m |= 1u << T.i1; if (T.v2 > -INFINITY) m |= 1u << T.i2;
        selmask[(size_t)h * S + t] = m;
    }
    __syncthreads();
}
__global__ void __launch_bounds__(512) k_route(const bf16* __restrict__ qa, const float* __restrict__ km, unsigned* __restrict__ selmask) {
    __shared__ float lds[4096 + 6 * 256];
    route_item_v0(blockIdx.x >> 5, blockIdx.x & 31, qa, km, selmask, lds);
}
__device__ __forceinline__ void scan_head_v0(int h, const float* __restrict__ flog, const float* __restrict__ bfg, float* __restrict__ cbn, double* lds  ) {
    const int tid = threadIdx.x; const float bh = bfg[h];
    float lf[16]; double s = 0.0;
#pragma unroll
    for (int i = 0; i < 16; ++i) { const float z = flog[(size_t)(tid * 16 + i) * 8 + h] + bh; lf[i] = fminf(z, 0.f) - log1pf(expf(-fabsf(z))); s += (double)lf[i]; }
    lds[tid] = s; __syncthreads();
    for (int o = 1; o < 512; o <<= 1) { double v = tid >= o ? lds[tid - o] : 0.0; __syncthreads(); lds[tid] += v; __syncthreads(); }
    double run = tid ? lds[tid - 1] : 0.0;
#pragma unroll
    for (int i = 0; i < 16; ++i) { run += (double)lf[i]; cbn[(size_t)h * S + tid * 16 + i] = (float)(-run * 1.4426950408889634); }
    __syncthreads();
}
__global__ void __launch_bounds__(512) k_scan(const float* __restrict__ flog, const float* __restrict__ bfg, float* __restrict__ cbn) {
    __shared__ double lds[512];
    scan_head_v0(blockIdx.x, flog, bfg, cbn, lds);
}
__global__ void __launch_bounds__(256) k_final(float* __restrict__ out, const unsigned long long* __restrict__ ssq, const float* __restrict__ g) {
    const int t = blockIdx.x; const float rstd = 1.0f / sqrtf((float)((double)ssq[t] * (1.0 / FIX)) * (1.0f / D) + EPS);
    for (int c = threadIdx.x; c < D; c += 256) out[(size_t)t * D + c] = out[(size_t)t * D + c] * rstd * g[c];
}

__global__ void __launch_bounds__(256) k_attn_naive(const bf16* __restrict__ Q, const bf16* __restrict__ K, const bf16* __restrict__ V, const float* __restrict__ cbn,
                                                    const unsigned* __restrict__ selmask, bf16* __restrict__ A, int mode) {
    __shared__ float qs[4][128]; __shared__ float ps[4][64];
    const int tid = threadIdx.x, lane = tid & 63, wid = tid >> 6, qi = blockIdx.x * 4 + wid, h = qi / S, t = qi % S;
    const bf16* qrow = Q + ((size_t)h * S + t) * HD; qs[wid][lane] = bf2f(qrow[lane]); qs[wid][lane + 64] = bf2f(qrow[lane + 64]);
    __syncthreads();
    const float slope2 = exp2f(-(float)(h + 1)) * LOG2E; const unsigned sm = mode ? selmask[(size_t)h * S + t] : 0xffffffffu;
    const float cbt = mode ? 0.f : cbn[(size_t)h * S + t];
    float m = -1e30f, l = 0.f, o0 = 0.f, o1 = 0.f;
    for (int kb = 0; kb <= t; kb += 64) {
        if (mode && !((sm >> (kb >> 8)) & 1u)) continue;
        const int key = kb + lane; const bool valid = key <= t; float s = -INFINITY;
        if (valid) { const bf16* kr = K + ((size_t)h * S + key) * HD; float a = 0.f;
            for (int d = 0; d < 128; d += 8) { const uint4 raw = *(const uint4*)(kr + d); const float* qq = &qs[wid][d];
                a += qq[0] * __uint_as_float(raw.x << 16) + qq[1] * __uint_as_float(raw.x & 0xffff0000u) + qq[2] * __uint_as_float(raw.y << 16) + qq[3] * __uint_as_float(raw.y & 0xffff0000u)
                   + qq[4] * __uint_as_float(raw.z << 16) + qq[5] * __uint_as_float(raw.z & 0xffff0000u) + qq[6] * __uint_as_float(raw.w << 16) + qq[7] * __uint_as_float(raw.w & 0xffff0000u); }
            s = mode ? a - slope2 * (float)(t - key) : a + cbn[(size_t)h * S + key] - cbt; }
        const float cm = wave_max(s), mn = fmaxf(m, cm), alpha = __builtin_amdgcn_exp2f(m - mn), p = valid ? __builtin_amdgcn_exp2f(s - mn) : 0.f;
        l = l * alpha + wave_sum(p); o0 *= alpha; o1 *= alpha; m = mn;
        ps[wid][lane] = p; asm volatile("s_waitcnt lgkmcnt(0)" ::: "memory"); __builtin_amdgcn_wave_barrier();
        const bf16* vb = V + ((size_t)h * S + kb) * HD;
        const int nk = (t - kb + 1) < 64 ? (t - kb + 1) : 64;
        for (int j = 0; j < nk; ++j) { const float pj = ps[wid][j]; o0 += pj * bf2f(vb[(size_t)j * HD + lane]); o1 += pj * bf2f(vb[(size_t)j * HD + lane + 64]); }
        asm volatile("s_waitcnt lgkmcnt(0)" ::: "memory"); __builtin_amdgcn_wave_barrier();
    }
    const float il = 1.0f / l;
    A[(size_t)t * MW + h * HD + lane] = f2bf(o0 * il); A[(size_t)t * MW + h * HD + lane + 64] = f2bf(o1 * il);
}
#ifndef NEWMASK
#define NEWMASK 0x1ff
#endif
extern "C" void kernel_launch(void* const* d_in, const int* in_sizes, int n_in, void* d_out, int out_size, void* d_ws, size_t ws_size, hipStream_t stream) {
    static int grid = 0;
    if (grid == 0) {
        if (n_in != 11 || in_sizes[0] != S * D || out_size != S * D || ws_size < WS_END) { fprintf(stderr, "kernel_launch: unexpected shapes / workspace (n_in %d, ws %zu); nothing launched\n", n_in, ws_size); grid = -1; return; }
        int dev = 0, cus = 0, per_cu = 0;
        if (hipGetDevice(&dev) != hipSuccess || hipDeviceGetAttribute(&cus, hipDeviceAttributeMultiprocessorCount, dev) != hipSuccess) { fprintf(stderr, "kernel_launch: device query failed\n"); grid = -1; return; }
        if (hipFuncSetAttribute((const void*)skel_fwd, hipFuncAttributeMaxDynamicSharedMemorySize, LDS_BYTES) != hipSuccess) { fprintf(stderr, "kernel_launch: hipFuncSetAttribute failed\n"); grid = -1; return; }
        if (hipOccupancyMaxActiveBlocksPerMultiprocessor(&per_cu, (const void*)skel_fwd, NWAVES * 64, LDS_BYTES) != hipSuccess || per_cu < 1) fprintf(stderr, "kernel_launch: note: occupancy query reports %d workgroups per CU\n", per_cu);
        (void)hipGetLastError();
        grid = cus;
    }
    if (grid < 0) return;
    (void)hipMemsetAsync((char*)d_ws + WS_CTL, 0, CTL_ZERO_BYTES, stream);
    Args a{};
    for (int i = 0; i < 11; ++i) a.in[i] = (const float*)d_in[i];
    a.out = (float*)d_out; a.ws = (unsigned char*)d_ws;
    const float* x = (const float*)d_in[0]; const float* g_mix = (const float*)d_in[1]; const float* w_in = (const float*)d_in[2]; const float* b_forget = (const float*)d_in[3];
    const float* w_pa = (const float*)d_in[4]; const float* w_pb = (const float*)d_in[5]; const float* w_out = (const float*)d_in[6]; const float* g_mlp = (const float*)d_in[7];
    const float* w_up = (const float*)d_in[8]; const float* w_dn = (const float*)d_in[9]; const float* g_fin = (const float*)d_in[10];
    unsigned char* ws = (unsigned char*)d_ws; float* out = (float*)d_out;
    bf16* WIN = (bf16*)(ws + WS_WIN); bf16* WA = (bf16*)(ws + WS_WA); bf16* WB = (bf16*)(ws + WS_WB); bf16* WOUT = (bf16*)(ws + WS_WOUT); bf16* WUP = (bf16*)(ws + WS_WUP); bf16* WDN = (bf16*)(ws + WS_WDN);
    bf16* XN = (bf16*)(ws + WS_XN); bf16* MERGED = (bf16*)(ws + WS_MERGED); bf16* QKV = (bf16*)(ws + WS_QKV); bf16* SIG = (bf16*)(ws + WS_SIG);
    bf16* AM = (bf16*)(ws + WS_AM); bf16* AF = (bf16*)(ws + WS_AF); bf16* X1G = (bf16*)(ws + WS_X1G); bf16* HB = (bf16*)(ws + WS_H);
    float* FLOG = (float*)(ws + WS_FLOG); float* CBN = (float*)(ws + WS_CBN); unsigned* SEL = (unsigned*)(ws + WS_SEL);
    unsigned long long* SSQ1 = (unsigned long long*)(ws + CT_SSQ1); unsigned long long* SSQ2 = (unsigned long long*)(ws + CT_SSQ2); float* KM = (float*)(ws + CT_KMEAN);
    auto run = [&](int lo, int hi, int li) { a.ph_lo = lo; a.ph_hi = hi; a.li = li; hipLaunchKernelGGL(skel_fwd, dim3(grid), dim3(NWAVES * 64), LDS_BYTES, stream, a); };
    auto isnew = [](int p) { return ((NEWMASK) >> p) & 1; };
#if MK_N_LAUNCHES == 1
    run(0, 9, 0);
    return;
#endif
    if (isnew(0)) run(0, 1, 0); else {
        k_transpose<<<dim3(NZ / 32, D / 32), 256, 0, stream>>>(w_in, D, DIN, 6144, 8, WIN);
        k_transpose<<<dim3(D / 32, MW / 32), 256, 0, stream>>>(w_pa, MW, D, 1 << 30, 0, WA);
        k_transpose<<<dim3(D / 32, MW / 32), 256, 0, stream>>>(w_pb, MW, D, 1 << 30, 0, WB);
        k_transpose<<<dim3(D / 32, D / 32), 256, 0, stream>>>(w_out, D, D, 1 << 30, 0, WOUT);
        k_transpose<<<dim3(FF / 32, D / 32), 256, 0, stream>>>(w_up, D, FF, 1 << 30, 0, WUP);
        k_transpose<<<dim3(D / 32, FF / 32), 256, 0, stream>>>(w_dn, FF, D, 1 << 30, 0, WDN);
        k_norm_x<<<S, 256, 0, stream>>>(x, g_mix, w_in, XN, FLOG); }
    if (isnew(1)) {
#ifdef EXP_NAIVE_FIRST
        k_gemm<EpiZ><<<dim3(NZ / 64, S / 64), 256, 0, stream>>>(XN, D, WIN, D, D, EpiZ{QKV, SIG});
#endif
        run(1, 2, 0);
#ifdef EXP_KMEAN_NAIVE
        k_kmean<<<256, 128, 0, stream>>>(QKV + 1 * QKV_T, KM);
#endif
    } else {
        k_gemm<EpiZ><<<dim3(NZ / 64, S / 64), 256, 0, stream>>>(XN, D, WIN, D, D, EpiZ{QKV, SIG});
        k_kmean<<<256, 128, 0, stream>>>(QKV + 1 * QKV_T, KM); }
    if (isnew(2)) run(2, 3, 0); else { k_route<<<256, 512, 0, stream>>>(QKV, KM, SEL); k_scan<<<8, 512, 0, stream>>>(FLOG, b_forget, CBN); }
    if (isnew(3)) run(3, 4, 0); else {
    k_attn_naive<<<NH * S / 4, 256, 0, stream>>>(QKV + 0 * QKV_T, QKV + 1 * QKV_T, QKV + 2 * QKV_T, CBN, SEL, AM, 1);
    k_attn_naive<<<NH * S / 4, 256, 0, stream>>>(QKV + 3 * QKV_T, QKV + 4 * QKV_T, QKV + 5 * QKV_T, CBN, SEL, AF, 0); }
    if (isnew(4)) run(4, 5, 0); else {
        k_gemm<EpiPa><<<dim3(D / 64, S / 64), 256, 0, stream>>>(AM, MW, WA, MW, MW, EpiPa{SIG, MERGED});
        k_gemm<EpiPb><<<dim3(D / 64, S / 64), 256, 0, stream>>>(AF, MW, WB, MW, MW, EpiPb{SIG, MERGED}); }
    if (isnew(5)) run(5, 6, 0); else k_gemm<EpiOut><<<dim3(D / 64, S / 64), 256, 0, stream>>>(MERGED, D, WOUT, D, D, EpiOut{x, g_mlp, out, X1G, SSQ1});
    if (isnew(6)) run(6, 7, 0); else k_gemm<EpiUp><<<dim3(FF / 64, S / 64), 256, 0, stream>>>(X1G, D, WUP, D, D, EpiUp{SSQ1, HB});
    if (isnew(7)) run(7, 8, 0); else k_gemm<EpiDn><<<dim3(D / 64, S / 64), 256, 0, stream>>>(HB, FF, WDN, FF, FF, EpiDn{out, SSQ2});
    if (isnew(8)) run(8, 9, 0); else k_final<<<S, 256, 0, stream>>>(out, SSQ2, g_fin);
}
```
